# Optimizing an MI355X kernel written in HIP

```python
import jax, jax.numpy as jnp
from jax import lax
import numpy as np

D_MODEL = 2048
BATCH = 4
SEQ = 2048
DEPTH = 2

GRID_W = 64
CTX_LEN = 256
F32 = jnp.float32
EPS = 1e-6
ROPE_THETA = 10000.0
Q_BLOCK = 128

HEAD_DIM = 128
GQA_HEADS = 8
GQA_KV_HEADS = 2
GQA_GROUP = GQA_HEADS // GQA_KV_HEADS
HGRN_HEADS = 4
HGRN_DK = 128
HGRN_DV = 128
HGRN_W = HGRN_HEADS * HGRN_DK
HGRN_CHUNK = 64
MLA_HEADS = 4
MLA_Q_RANK = 512
MLA_KV_RANK = 256
MLA_NOPE = 128
MLA_ROPE = 64
MLA_V = 128
MLA_QK = MLA_NOPE + MLA_ROPE

MIX_WIDTH = GQA_HEADS * HEAD_DIM + HGRN_HEADS * HGRN_DV + MLA_HEADS * MLA_V
IN_SIZES = (GQA_HEADS * HEAD_DIM, GQA_KV_HEADS * HEAD_DIM, GQA_KV_HEADS * HEAD_DIM,
            HGRN_W, HGRN_HEADS * HGRN_DV, HGRN_W, HGRN_W, HGRN_HEADS * HGRN_DV,
            MLA_Q_RANK, MLA_KV_RANK, MLA_ROPE)
IN_WIDTH = sum(IN_SIZES)
FFN_HIDDEN = 5504
N_MOD = 9

kernel_name = 'hybrid_dit_gqa_hgrn2_mla_macaron'


def rms_norm(x, gain=None):
    xf = x.astype(F32)
    y = xf * lax.rsqrt(jnp.mean(xf * xf, axis=-1, keepdims=True) + EPS)
    if gain is not None:
        y = y * gain.astype(F32)
    return y.astype(x.dtype)


def modulation(cvec, w_mod, b_mod):
    m = jax.nn.silu(cvec) @ w_mod + b_mod
    m = m.reshape(m.shape[:-1] + (N_MOD, D_MODEL))
    return [m[..., None, i, :] for i in range(N_MOD)]


def modulate(x, shift, scale):
    return rms_norm(x) * (1.0 + scale) + shift


def swiglu(h, w_in, w_out):
    gate, up = jnp.split(h @ w_in, 2, axis=-1)
    return (jax.nn.silu(gate) * up) @ w_out


def axial_rope_tables(rows, rot_dim):
    row = jnp.repeat(jnp.arange(rows, dtype=F32), GRID_W)
    col = jnp.tile(jnp.arange(GRID_W, dtype=F32), rows)
    axis_dim = rot_dim // 2
    inv_freq = ROPE_THETA ** (-jnp.arange(0, axis_dim, 2, dtype=F32) / axis_dim)
    ang_r = row[:, None] * inv_freq
    ang_c = col[:, None] * inv_freq
    ang = jnp.concatenate([ang_r, ang_r, ang_c, ang_c], axis=-1)
    return jnp.cos(ang), jnp.sin(ang)


def apply_rope(x, cos, sin):
    a1, a2, b1, b2 = jnp.split(x, 4, axis=-1)
    rot = jnp.concatenate([-a2, a1, -b2, b1], axis=-1)
    y = x.astype(F32) * cos[:, None, :] + rot.astype(F32) * sin[:, None, :]
    return y.astype(x.dtype)


def block_attention(q, k, v, scale):
    b, kh, g, tq, d = q.shape
    nb = tq // Q_BLOCK
    qb = q.reshape(b, kh, g, nb, Q_BLOCK, d).transpose(3, 0, 1, 2, 4, 5)

    def one_block(q_blk):
        s = jnp.einsum('bkgqd,bksd->bkgqs', q_blk, k).astype(F32) * scale
        p = jax.nn.softmax(s, axis=-1).astype(v.dtype)
        return jnp.einsum('bkgqs,bkse->bkgqe', p, v)

    ob = lax.map(one_block, qb)
    return ob.transpose(1, 2, 3, 0, 4, 5).reshape(b, kh, g, tq, v.shape[-1])


def gla_chunkwise(q, k, v, log_f, s0):
    b, h, t, dk = q.shape
    dv = v.shape[-1]
    n = t // HGRN_CHUNK

    def chunks(a):
        return a.astype(F32).reshape(b, h, n, HGRN_CHUNK, a.shape[-1]).transpose(2, 0, 1, 3, 4)

    lower_tri = jnp.tril(jnp.ones((HGRN_CHUNK, HGRN_CHUNK), dtype=bool))[:, :, None]

    def step(state, inp):
        qc, kc, vc, gc = inp
        cum = jnp.cumsum(gc, axis=-2)
        o_inter = jnp.einsum('bhtk,bhkv->bhtv', qc * jnp.exp(cum), state)
        rel = jnp.where(lower_tri, cum[:, :, :, None, :] - cum[:, :, None, :, :], -jnp.inf)
        scores = jnp.einsum('bhtk,bhtsk,bhsk->bhts', qc, jnp.exp(rel), kc)
        o = o_inter + jnp.einsum('bhts,bhsv->bhtv', scores, vc)
        last = cum[:, :, -1:, :]
        new_state = (jnp.exp(last[:, :, 0, :])[..., None] * state
                     + jnp.einsum('bhsk,bhsv->bhkv', kc * jnp.exp(last - cum), vc))
        return new_state, o

    s_fin, o = lax.scan(step, s0, (chunks(q), chunks(k), chunks(v), chunks(log_f)))
    return o.transpose(1, 2, 0, 3, 4).reshape(b, h, t, dv), s_fin


def hgrn_direction(q, i, z, lb, s0):
    zf = z.astype(F32)
    lbf = lb.reshape(HGRN_HEADS, HGRN_DK)
    log_f = jnp.logaddexp(jnp.log(lbf), jnp.log1p(-lbf) + jax.nn.log_sigmoid(zf))
    k = (1.0 - lbf) * jax.nn.sigmoid(-zf)
    o, s = gla_chunkwise(jnp.swapaxes(q, 1, 2) * HGRN_DK ** -0.5, jnp.swapaxes(k, 1, 2),
                         jnp.swapaxes(i, 1, 2), jnp.swapaxes(log_f, 1, 2), s0)
    return jnp.swapaxes(o, 1, 2).astype(i.dtype), s


def hgrn2_bidirectional(q_l, i_l, zf_l, zb_l, q_c, i_c, zf_c, zb_c, lb):
    s0 = jnp.zeros((q_l.shape[0], HGRN_HEADS, HGRN_DK, HGRN_DV), F32)
    flip = lambda a: jnp.flip(a, axis=1)
    o_cf, s_f = hgrn_direction(q_c, i_c, zf_c, lb[0], s0)
    o_lf, _ = hgrn_direction(q_l, i_l, zf_l, lb[0], s_f)
    o_cb, s_b = hgrn_direction(flip(q_c), flip(i_c), flip(zb_c), lb[1], s0)
    o_lb, _ = hgrn_direction(flip(q_l), flip(i_l), flip(zb_l), lb[1], s_b)
    return o_lf + flip(o_lb), o_cf + flip(o_cb)


def split_in(p):
    offsets = []
    acc = 0
    for s in IN_SIZES[:-1]:
        acc += s
        offsets.append(acc)
    return jnp.split(p, offsets, axis=-1)


def heads(a, n):
    return a.reshape(a.shape[0], a.shape[1], n, -1)


def kv_layout(a):
    return jnp.swapaxes(a, 1, 2)


def gqa_q_layout(a):
    return a.reshape(a.shape[0], a.shape[1], GQA_KV_HEADS, GQA_GROUP, HEAD_DIM).transpose(0, 2, 3, 1, 4)


def merge_heads(o):
    return o.transpose(0, 3, 1, 2, 4).reshape(o.shape[0], o.shape[3], -1)


def token_mixers(h_lat, h_ctx, w_in, w_uq, w_ukv, w_out, gqa_q_gain, gqa_k_gain, mla_q_gain,
                 mla_kv_gain, lb, hgrn_norm_gain, rope_h, rope_r, need_ctx):
    t_lat = h_lat.shape[1]
    gq_l, gk_l, gv_l, hq_l, hi_l, hf_l, hb_l, hg_l, cq_l, ckv_l, kr_l = split_in(h_lat @ w_in)
    gq_c, gk_c, gv_c, hq_c, hi_c, hf_c, hb_c, hg_c, cq_c, ckv_c, kr_c = split_in(h_ctx @ w_in)

    k_a = jnp.concatenate([kv_layout(apply_rope(rms_norm(heads(gk_l, GQA_KV_HEADS), gqa_k_gain), *rope_h)),
                           kv_layout(rms_norm(heads(gk_c, GQA_KV_HEADS), gqa_k_gain))], axis=2)
    v_a = jnp.concatenate([kv_layout(heads(gv_l, GQA_KV_HEADS)), kv_layout(heads(gv_c, GQA_KV_HEADS))], axis=2)
    q_a = gqa_q_layout(apply_rope(rms_norm(heads(gq_l, GQA_HEADS), gqa_q_gain), *rope_h))
    o_a = merge_heads(block_attention(q_a, k_a, v_a, HEAD_DIM ** -0.5))

    def mla_q(cq):
        r = heads(rms_norm(cq, mla_q_gain) @ w_uq, MLA_HEADS)
        return r[..., :MLA_NOPE], r[..., MLA_NOPE:]

    def mla_kv(ckv, kr):
        r = heads(rms_norm(ckv, mla_kv_gain) @ w_ukv, MLA_HEADS)
        k = jnp.concatenate([r[..., :MLA_NOPE], jnp.broadcast_to(kr, r.shape[:-1] + (MLA_ROPE,))], axis=-1)
        return k, r[..., MLA_NOPE:]

    k_cl, v_cl = mla_kv(ckv_l, apply_rope(kr_l[:, :, None, :], *rope_r))
    k_cc, v_cc = mla_kv(ckv_c, kr_c[:, :, None, :])
    k_m = jnp.concatenate([kv_layout(k_cl), kv_layout(k_cc)], axis=2)
    v_m = jnp.concatenate([kv_layout(v_cl), kv_layout(v_cc)], axis=2)
    qn_l, qr_l = mla_q(cq_l)
    q_m = kv_layout(jnp.concatenate([qn_l, apply_rope(qr_l, *rope_r)], axis=-1))[:, :, None]
    o_m = merge_heads(block_attention(q_m, k_m, v_m, MLA_QK ** -0.5))

    o_bl, o_bc = hgrn2_bidirectional(heads(hq_l, HGRN_HEADS), heads(hi_l, HGRN_HEADS), heads(hf_l, HGRN_HEADS),
                                     heads(hb_l, HGRN_HEADS), heads(hq_c, HGRN_HEADS), heads(hi_c, HGRN_HEADS),
                                     heads(hf_c, HGRN_HEADS), heads(hb_c, HGRN_HEADS), lb)

    def hgrn_out(o, g):
        y = rms_norm(o, hgrn_norm_gain) * jax.nn.silu(heads(g, HGRN_HEADS))
        return y.reshape(y.shape[0], y.shape[1], -1)

    y_lat = jnp.concatenate([o_a, hgrn_out(o_bl, hg_l), o_m], axis=-1) @ w_out
    if not need_ctx:
        return y_lat, None

    q_ac = gqa_q_layout(rms_norm(heads(gq_c, GQA_HEADS), gqa_q_gain))
    o_ac = merge_heads(block_attention(q_ac, k_a[:, :, t_lat:], v_a[:, :, t_lat:], HEAD_DIM ** -0.5))
    qn_c, qr_c = mla_q(cq_c)
    q_mc = kv_layout(jnp.concatenate([qn_c, qr_c], axis=-1))[:, :, None]
    o_mc = merge_heads(block_attention(q_mc, k_m[:, :, t_lat:], v_m[:, :, t_lat:], MLA_QK ** -0.5))
    y_ctx = jnp.concatenate([o_ac, hgrn_out(o_bc, hg_c), o_mc], axis=-1) @ w_out
    return y_lat, y_ctx


def setup_inputs(seed: int = 0) -> dict:
    key = jax.random.key(seed)
    ks = jax.random.split(key, 24)

    def nrm(k, shape, scale):
        return jax.random.normal(k, shape, F32) * scale

    d = D_MODEL
    return {
        'x': nrm(ks[0], (BATCH, SEQ, d), 1.0),
        'c': nrm(ks[1], (BATCH, d), 1.0),
        'ctx': nrm(ks[2], (BATCH, CTX_LEN, d), 1.0),
        'c_ctx': nrm(ks[3], (d,), 1.0),
        'w_mod': nrm(ks[4], (DEPTH, d, N_MOD * d), 0.5 * d ** -0.5),
        'b_mod': nrm(ks[5], (DEPTH, N_MOD * d), 0.02),
        'w_ffn1_in': nrm(ks[6], (DEPTH, d, 2 * FFN_HIDDEN), d ** -0.5),
        'w_ffn1_out': nrm(ks[7], (DEPTH, FFN_HIDDEN, d), FFN_HIDDEN ** -0.5),
        'w_in': nrm(ks[8], (DEPTH, d, IN_WIDTH), d ** -0.5),
        'w_uq': nrm(ks[9], (DEPTH, MLA_Q_RANK, MLA_HEADS * MLA_QK), MLA_Q_RANK ** -0.5),
        'w_ukv': nrm(ks[10], (DEPTH, MLA_KV_RANK, MLA_HEADS * (MLA_NOPE + MLA_V)), MLA_KV_RANK ** -0.5),
        'w_out': nrm(ks[11], (DEPTH, MIX_WIDTH, d), MIX_WIDTH ** -0.5),
        'gqa_q_gain': 1.0 + nrm(ks[12], (DEPTH, HEAD_DIM), 0.02),
        'gqa_k_gain': 1.0 + nrm(ks[13], (DEPTH, HEAD_DIM), 0.02),
        'mla_q_gain': 1.0 + nrm(ks[14], (DEPTH, MLA_Q_RANK), 0.02),
        'mla_kv_gain': 1.0 + nrm(ks[15], (DEPTH, MLA_KV_RANK), 0.02),
        'hgrn_lb_logits': nrm(ks[16], (2, DEPTH, HGRN_W), 0.5),
        'hgrn_norm_gain': 1.0 + nrm(ks[17], (DEPTH, HGRN_DV), 0.02),
        'w_ffn2_in': nrm(ks[18], (DEPTH, d, 2 * FFN_HIDDEN), d ** -0.5),
        'w_ffn2_out': nrm(ks[19], (DEPTH, FFN_HIDDEN, d), FFN_HIDDEN ** -0.5),
        'final_gain': 1.0 + nrm(ks[20], (d,), 0.02),
    }


def reference(x, c, ctx, c_ctx, w_mod, b_mod, w_ffn1_in, w_ffn1_out, w_in, w_uq, w_ukv, w_out,
              gqa_q_gain, gqa_k_gain, mla_q_gain, mla_kv_gain, hgrn_lb_logits, hgrn_norm_gain,
              w_ffn2_in, w_ffn2_out, final_gain):
    rows = x.shape[1] // GRID_W
    rope_h = axial_rope_tables(rows, HEAD_DIM)
    rope_r = axial_rope_tables(rows, MLA_ROPE)
    lb_cum = jnp.cumsum(jax.nn.softmax(hgrn_lb_logits.astype(F32), axis=1), axis=1)
    lower_bounds = lb_cum - lb_cum[:, :1]

    x_lat, x_ctx = x, ctx
    for l in range(DEPTH):
        last = l == DEPTH - 1
        m_l = modulation(c, w_mod[l], b_mod[l])
        m_c = modulation(c_ctx, w_mod[l], b_mod[l])
        x_lat = x_lat + 0.5 * m_l[2] * swiglu(modulate(x_lat, m_l[0], m_l[1]), w_ffn1_in[l], w_ffn1_out[l])
        x_ctx = x_ctx + 0.5 * m_c[2] * swiglu(modulate(x_ctx, m_c[0], m_c[1]), w_ffn1_in[l], w_ffn1_out[l])
        y_lat, y_ctx = token_mixers(modulate(x_lat, m_l[3], m_l[4]), modulate(x_ctx, m_c[3], m_c[4]),
                                    w_in[l], w_uq[l], w_ukv[l], w_out[l], gqa_q_gain[l], gqa_k_gain[l],
                                    mla_q_gain[l], mla_kv_gain[l], lower_bounds[:, l], hgrn_norm_gain[l],
                                    rope_h, rope_r, not last)
        x_lat = x_lat + m_l[5] * y_lat
        x_lat = x_lat + 0.5 * m_l[8] * swiglu(modulate(x_lat, m_l[6], m_l[7]), w_ffn2_in[l], w_ffn2_out[l])
        if not last:
            x_ctx = x_ctx + m_c[5] * y_ctx
            x_ctx = x_ctx + 0.5 * m_c[8] * swiglu(modulate(x_ctx, m_c[6], m_c[7]), w_ffn2_in[l], w_ffn2_out[l])
    return rms_norm(x_lat, final_gain)
```

```cpp
#include <hip/hip_runtime.h>
#include <hip/hip_cooperative_groups.h>
#include <cstdio>
#include <cstdint>
namespace cg = cooperative_groups;

#ifndef ONE_LAUNCH
#define ONE_LAUNCH 1
#endif

typedef unsigned short bf16_t;
typedef short bf16x8 __attribute__((ext_vector_type(8)));
typedef short s16x4 __attribute__((ext_vector_type(4)));
typedef float f32x4 __attribute__((ext_vector_type(4)));
typedef float f32x2 __attribute__((ext_vector_type(2)));
typedef float f32x16 __attribute__((ext_vector_type(16)));
typedef unsigned u32x4 __attribute__((ext_vector_type(4)));
typedef unsigned u32x2 __attribute__((ext_vector_type(2)));
#define LAS __attribute__((address_space(3)))

constexpr int DM = 2048, NB = 4, SEQ = 2048, CTXL = 256, NLAT = NB * SEQ, NCTX = NB * CTXL, NTOK = NLAT + NCTX;
constexpr int FH = 5504, INW = 4928, INWP = 5120, MODW = 9 * DM;
constexpr int SKV = SEQ + CTXL;
constexpr float EPS = 1e-6f;
constexpr float LOG2E = 1.4426950408889634f;
constexpr int PC_GQ = 0, PC_GK = 1024, PC_GV = 1280, PC_HQ = 1536, PC_HI = 2048, PC_HF = 2560, PC_HB = 3072, PC_HG = 3584, PC_CQ = 4096, PC_CKV = 4608, PC_KR = 4864;
constexpr int NCHUNK = 36, NCHAIN = 32;

constexpr size_t al256(size_t x) { return (x + 255) / 256 * 256; }
constexpr size_t WS_CTRL = 0;
constexpr size_t WS_ROPE = 4096;
constexpr size_t WS_MOD = WS_ROPE + 32768;
constexpr size_t WS_MPART = WS_MOD + al256((size_t)2 * 5 * MODW * 4);
constexpr size_t WS_W1IN = WS_MPART + al256((size_t)8 * 2 * 5 * MODW * 4);
constexpr size_t SZ_WFIN = (size_t)2 * FH * DM * 2;
constexpr size_t WS_W2IN = WS_W1IN + 2 * SZ_WFIN;
constexpr size_t WS_W1OUT = WS_W2IN + 2 * SZ_WFIN;
constexpr size_t SZ_WFOUT = (size_t)DM * FH * 2;
constexpr size_t WS_W2OUT = WS_W1OUT + 2 * SZ_WFOUT;
constexpr size_t WS_WIN = WS_W2OUT + 2 * SZ_WFOUT;
constexpr size_t SZ_WIN = (size_t)INWP * DM * 2;
constexpr size_t WS_WOUT = WS_WIN + 2 * SZ_WIN;
constexpr size_t SZ_WOUT = (size_t)DM * DM * 2;
constexpr size_t WS_WUQ = WS_WOUT + 2 * SZ_WOUT;
constexpr size_t SZ_WUQ = (size_t)768 * 512 * 2;
constexpr size_t WS_WUKV = WS_WUQ + 2 * SZ_WUQ;
constexpr size_t SZ_WUKV = (size_t)1024 * 256 * 2;
constexpr size_t WS_X = WS_WUKV + 2 * SZ_WUKV;
constexpr size_t WS_H = WS_X + (size_t)NTOK * DM * 4;
constexpr size_t WS_GP = WS_H + (size_t)NTOK * DM * 2;
constexpr size_t WS_QA = WS_GP + (size_t)NTOK * INWP * 4;
constexpr size_t WS_KA = WS_QA + (size_t)NTOK * 1024 * 2;
constexpr size_t WS_VA = WS_KA + (size_t)NTOK * 256 * 2;
constexpr size_t WS_CQN = WS_VA + (size_t)NTOK * 256 * 2;
constexpr size_t WS_CKVN = WS_CQN + (size_t)NTOK * 512 * 2;
constexpr size_t WS_UQ = WS_CKVN + (size_t)NTOK * 256 * 2;
constexpr size_t WS_UKV = WS_UQ + (size_t)NTOK * 768 * 2;
constexpr size_t WS_KR = WS_UKV + (size_t)NTOK * 1024 * 2;
constexpr size_t WS_MIX = WS_KR + (size_t)NTOK * 64 * 2;
constexpr size_t WS_ST = WS_MIX + (size_t)NTOK * DM * 2;
constexpr size_t WS_DEC = WS_ST + (size_t)NCHAIN * NCHUNK * 16384 * 4;
constexpr size_t WS_QE = WS_DEC + (size_t)NCHAIN * NCHUNK * 128 * 4;
constexpr size_t WS_OI = WS_QE + (size_t)NCHAIN * NCHUNK * 8192 * 2;
constexpr size_t WS_PART = WS_OI + (size_t)2 * NTOK * 512 * 4;
constexpr size_t WS_ST2 = WS_PART + (size_t)8 * NCTX * DM * 4;
constexpr size_t WS_BAR = WS_ST2 + (size_t)NCHAIN * NCHUNK * 16384 * 4;
constexpr size_t WS_END = WS_BAR + 16384;

constexpr int LDS_BYTES = 160 * 1024;
constexpr int LDS_ITEM_OFF = 159 * 1024;

struct Params { const float* in[21]; float* out; unsigned char* ws; int ph_lo, ph_hi; };

__device__ __forceinline__ unsigned cvt_pk_bf16(float lo, float hi) { unsigned r; asm("v_cvt_pk_bf16_f32 %0, %1, %2" : "=v"(r) : "v"(lo), "v"(hi)); return r; }
__device__ __forceinline__ bf16_t f2bf(float x) { return (bf16_t)(cvt_pk_bf16(x, 0.f) & 0xffffu); }
__device__ __forceinline__ float bf2f(bf16_t b) { return __uint_as_float(((unsigned)b) << 16); }
__device__ __forceinline__ f32x4 bf4_to_f4(u32x2 w) { return (f32x4){__uint_as_float(w.x << 16), __uint_as_float(w.x & 0xffff0000u), __uint_as_float(w.y << 16), __uint_as_float(w.y & 0xffff0000u)}; }
__device__ __forceinline__ float wave_sum(float v) {
#pragma unroll
    for (int o = 32; o >= 1; o >>= 1) v += __shfl_xor(v, o, 64);
    return v;
}
__device__ __forceinline__ float half_sum(float v) {
#pragma unroll
    for (int o = 16; o >= 1; o >>= 1) v += __shfl_xor(v, o, 64);
    return v;
}
__device__ __forceinline__ float sigmoidf_(float x) { return 1.f / (1.f + __expf(-x)); }
__device__ __forceinline__ int otid() { int t = threadIdx.x; asm volatile("" : "+v"(t)); return t; }
__device__ __forceinline__ int crow(int r, int hi) { return (r & 3) + 8 * (r >> 2) + 4 * hi; }

namespace pg8 {
constexpr int BM = 256, BK = 64, HALF = 128, HTB = HALF * BK * 2, STAGE_BYTES = 8 * HTB, NXCD = 8, WGM = 8;
__host__ __device__ __forceinline__ int lds_byte(int r, int c) { const int st = (r >> 4) * 2 + (c >> 5), rr = r & 15, cc = c & 31, ob = rr * 64 + cc * 2; return st * 1024 + (ob ^ (((ob >> 9) & 1) << 5)); }
__host__ __device__ __forceinline__ void stage_rc(int b, int& R, int& C) { const int st = b / 1024, sb = b % 1024, swz = sb ^ (((sb >> 9) & 1) << 5); R = (st >> 1) * 16 + swz / 64; C = (st & 1) * 32 + (swz % 64) / 2; }
struct Unit { int pm, pn, k0, nk, part, ks; };
struct Gemm { const bf16_t* A; const bf16_t* Bt; int M, N, K; };
struct StaticOrder {
    int nM, nN, nwg, G, c, nkt, split;
    __device__ __forceinline__ void init(int M, int N, int K, int G_, int c_, int split_) { nM = M / BM; nN = N / BM; G = G_; c = c_; nkt = K / BK; split = (split_ && nM == 36 && nN == 8 && G_ == 256) ? 1 : 0; if (split) nM = 32; nwg = nM * nN; }
    __device__ __forceinline__ void decode(int wg, Unit& u) const {
        int wgid = wg; { const int q = nwg / NXCD, r = nwg % NXCD, xcd = wgid % NXCD, off = wgid / NXCD; wgid = (xcd < r ? xcd * (q + 1) : r * (q + 1) + (xcd - r) * q) + off; }
        const int nig = WGM * nN, gid = wgid / nig, fm = gid * WGM, gsz = (nM - fm) < WGM ? (nM - fm) : WGM;
        u.pm = fm + ((wgid % nig) % gsz); u.pn = (wgid % nig) / gsz;
    }
    __device__ __forceinline__ bool next(int i, Unit& u) const {
        const long L = (long)i * G + c;
        if (L < nwg) { decode((int)L, u); u.k0 = 0; u.nk = nkt; u.part = 0; u.ks = 0; return true; }
        if (!split || i != 1) return false;
        const int j = c, t = j >> 3, s = j & 7;
        u.pm = 32 + (t >> 3); u.pn = t & 7;
        const int npair = nkt >> 1, base = npair >> 3, rem = npair & 7;
        const int p0 = s * base + (s < rem ? s : rem), np = base + (s < rem ? 1 : 0);
        u.k0 = 2 * p0; u.nk = 2 * np; u.part = 1; u.ks = s; return true;
    }
};

template <class Epi>
__device__ __forceinline__ void gemm_phase(LAS unsigned char* lds, const Gemm g, const StaticOrder S, const Epi E) {
    const int tid = otid(), wid = __builtin_amdgcn_readfirstlane(tid >> 6), lane = tid & 63, wr = wid >> 2, wc = wid & 3, fr = lane & 15, fq = lane >> 4;
    const int K = g.K;
    unsigned voffA[2];
#pragma unroll
    for (int i = 0; i < 2; ++i) { int R, C; stage_rc(tid * 16 + i * 8192, R, C); voffA[i] = (unsigned)(R * K + C) * 2u; }
    const size_t kstep = (size_t)(BK * 2);
    const size_t hstep = (size_t)HALF * K * 2;
    const size_t tstep = 2 * hstep;
    const unsigned ldsw = (unsigned)wid * 1024u;
    const int aoff = lds_byte(wr * 64 + fr, fq * 8), boff = lds_byte(wc * 32 + fr, fq * 8);
#define PG8_SA(b, h) (((b) * 2 + (h)) * HTB)
#define PG8_SB(b, h) ((4 + (b) * 2 + (h)) * HTB)
#define PG8_STAGE(bufoff, gbase, voff) do { _Pragma("unroll") for (int _i = 0; _i < 2; ++_i) \
        __builtin_amdgcn_global_load_lds((const unsigned*)((const char*)(gbase) + (voff)[_i]), (LAS unsigned*)(lds + (bufoff) + ldsw + _i * 8192), 16, 0, 0); } while (0)
#define PG8_LDA(dst, b, h) do { _Pragma("unroll") for (int m = 0; m < 4; ++m) _Pragma("unroll") for (int k = 0; k < 2; ++k) dst[m][k] = *(const LAS bf16x8*)(lds + PG8_SA(b, h) + aoff + m * 2048 + k * 1024); } while (0)
#define PG8_LDB(dst, b, h) do { _Pragma("unroll") for (int n = 0; n < 2; ++n) _Pragma("unroll") for (int k = 0; k < 2; ++k) dst[n][k] = *(const LAS bf16x8*)(lds + PG8_SB(b, h) + boff + n * 2048 + k * 1024); } while (0)
#define PG8_MMA(ai, bj, At, Bt) do { __builtin_amdgcn_s_setprio(1); _Pragma("unroll") for (int m = 0; m < 4; ++m) _Pragma("unroll") for (int n = 0; n < 2; ++n) _Pragma("unroll") for (int k = 0; k < 2; ++k) \
        acc[ai][bj][m][n] = __builtin_amdgcn_mfma_f32_16x16x32_bf16(Bt[n][k], At[m][k], acc[ai][bj][m][n], 0, 0, 0); __builtin_amdgcn_s_setprio(0); } while (0)
#define PG8_WAIT_V(n) asm volatile("s_waitcnt vmcnt(" #n ")" ::: "memory")
#define PG8_WAIT_L(n) asm volatile("s_waitcnt lgkmcnt(" #n ")" ::: "memory")
#define PG8_BAR __builtin_amdgcn_s_barrier()
#define PG8_SCHED __builtin_amdgcn_sched_barrier(0)
    Unit cur, nxt; int ui = 0;
    if (!S.next(0, cur)) return;
    f32x4 acc[2][2][4][2];
#pragma unroll
    for (int a = 0; a < 2; ++a)
#pragma unroll
        for (int b = 0; b < 2; ++b)
#pragma unroll
            for (int m = 0; m < 4; ++m)
#pragma unroll
                for (int n = 0; n < 2; ++n) acc[a][b][m][n] = (f32x4){0.f, 0.f, 0.f, 0.f};
    bf16x8 At[4][2], B0[2][2], B1[2][2];
    const char* cA = (const char*)g.A + (size_t)cur.pm * tstep + (size_t)cur.k0 * kstep; const char* cB = (const char*)g.Bt + (size_t)cur.pn * tstep + (size_t)cur.k0 * kstep;
    PG8_STAGE(PG8_SB(0, 0), cB, voffA); PG8_STAGE(PG8_SA(0, 0), cA, voffA); PG8_STAGE(PG8_SB(0, 1), cB + hstep, voffA); PG8_STAGE(PG8_SA(0, 1), cA + hstep, voffA);
    if (wr == 1) PG8_BAR;
    PG8_WAIT_V(4); PG8_BAR;
    PG8_STAGE(PG8_SB(1, 0), cB + kstep, voffA); PG8_STAGE(PG8_SA(1, 0), cA + kstep, voffA); PG8_STAGE(PG8_SB(1, 1), cB + hstep + kstep, voffA);
    PG8_WAIT_V(6); PG8_BAR;
    for (;;) {
        const bool has_next = S.next(ui + 1, nxt);
        const char* nA = has_next ? (const char*)g.A + (size_t)nxt.pm * tstep + (size_t)nxt.k0 * kstep : cA; const char* nB = has_next ? (const char*)g.Bt + (size_t)nxt.pn * tstep + (size_t)nxt.k0 * kstep : cB;
        const int nt = cur.nk;
        for (int t = 0; t < nt; t += 2) {
            const bool last = (t == nt - 2);
            const char* a1 = cA + (size_t)(t + 1) * kstep;
            const char* a2 = last ? nA : cA + (size_t)(t + 2) * kstep; const char* b2 = last ? nB : cB + (size_t)(t + 2) * kstep;
            const char* a3 = a2 + kstep; const char* b3 = b2 + kstep;
            PG8_LDB(B0, 0, 0); PG8_SCHED; PG8_LDA(At, 0, 0); PG8_STAGE(PG8_SA(1, 1), a1 + hstep, voffA);
            PG8_WAIT_L(8); PG8_BAR; PG8_WAIT_L(0); PG8_MMA(0, 0, At, B0); PG8_BAR; PG8_SCHED;
            PG8_LDB(B1, 0, 1); PG8_STAGE(PG8_SB(0, 0), b2, voffA);
            PG8_BAR; PG8_WAIT_L(0); PG8_MMA(0, 1, At, B1); PG8_BAR;
            PG8_LDA(At, 0, 1); PG8_STAGE(PG8_SA(0, 0), a2, voffA);
            PG8_BAR; PG8_WAIT_L(0); PG8_MMA(1, 0, At, B0); PG8_BAR; PG8_SCHED;
            PG8_STAGE(PG8_SB(0, 1), b2 + hstep, voffA);
            PG8_WAIT_V(6); PG8_BAR; PG8_MMA(1, 1, At, B1); PG8_BAR;
            PG8_LDB(B0, 1, 0); PG8_SCHED; PG8_LDA(At, 1, 0); PG8_STAGE(PG8_SA(0, 1), a2 + hstep, voffA);
            PG8_WAIT_L(8); PG8_BAR; PG8_WAIT_L(0); PG8_MMA(0, 0, At, B0); PG8_BAR; PG8_SCHED;
            PG8_LDB(B1, 1, 1); PG8_STAGE(PG8_SB(1, 0), b3, voffA);
            PG8_BAR; PG8_WAIT_L(0); PG8_MMA(0, 1, At, B1); PG8_BAR;
            PG8_LDA(At, 1, 1); PG8_STAGE(PG8_SA(1, 0), a3, voffA);
            PG8_BAR; PG8_WAIT_L(0); PG8_MMA(1, 0, At, B0); PG8_BAR; PG8_SCHED;
            PG8_STAGE(PG8_SB(1, 1), b3 + hstep, voffA);
            PG8_WAIT_V(6); PG8_BAR; PG8_MMA(1, 1, At, B1); PG8_BAR;
        }
        E(acc, cur, wr, wc, fr, fq);
        if (!has_next) break;
#pragma unroll
        for (int a = 0; a < 2; ++a)
#pragma unroll
            for (int b = 0; b < 2; ++b)
#pragma unroll
                for (int m = 0; m < 4; ++m)
#pragma unroll
                    for (int n = 0; n < 2; ++n) acc[a][b][m][n] = (f32x4){0.f, 0.f, 0.f, 0.f};
        cur = nxt; cA = nA; cB = nB; ++ui;
    }
    PG8_WAIT_V(0);
    if (wr == 0) PG8_BAR;
    PG8_BAR;
#undef PG8_SA
#undef PG8_SB
#undef PG8_STAGE
#undef PG8_LDA
#undef PG8_LDB
#undef PG8_MMA
#undef PG8_WAIT_V
#undef PG8_WAIT_L
#undef PG8_BAR
#undef PG8_SCHED
}
}

typedef const f32x4 (&AccRef)[2][2][4][2];

struct EpiSwiglu {
    bf16_t* G;
    __device__ __forceinline__ void operator()(AccRef acc, const pg8::Unit& u, int wr, int wc, int fr, int fq) const {
        const int row0 = u.pm * 256 + wr * 64 + fr, col0 = u.pn * 128 + wc * 16 + 4 * fq;
#pragma unroll
        for (int ai = 0; ai < 2; ++ai)
#pragma unroll
            for (int m = 0; m < 4; ++m) { bf16_t* rowp = G + (size_t)(row0 + ai * 128 + m * 16) * FH + col0;
#pragma unroll
                for (int bj = 0; bj < 2; ++bj) { const f32x4 gq = acc[ai][bj][m][0], uq = acc[ai][bj][m][1]; float v[4];
#pragma unroll
                    for (int i = 0; i < 4; ++i) v[i] = gq[i] * uq[i] * __builtin_amdgcn_rcpf(1.f + __builtin_amdgcn_exp2f(-gq[i] * LOG2E));
                    u32x2 w; w.x = cvt_pk_bf16(v[0], v[1]); w.y = cvt_pk_bf16(v[2], v[3]);
                    *(u32x2*)(rowp + bj * 64) = w; } }
    }
};
struct EpiResid {
    float* X; float* PART; const float* SRC; const float* gate; float coef;
    __device__ __forceinline__ void operator()(AccRef acc, const pg8::Unit& u, int wr, int wc, int fr, int fq) const {
        const int row0 = u.pm * 256 + wr * 64 + fr, col0 = u.pn * 256 + wc * 32 + 4 * fq;
        const int v = u.pm < 32 ? (u.pm >> 3) : 4;
        f32x4 gv[2][2];
#pragma unroll
        for (int bj = 0; bj < 2; ++bj)
#pragma unroll
            for (int n = 0; n < 2; ++n) gv[bj][n] = *(const f32x4*)(gate + (size_t)v * MODW + col0 + bj * 128 + n * 16) * coef;
        const bool part = u.part != 0;
        float* base = part ? PART + ((size_t)u.ks * NCTX - NLAT) * DM : X;
#pragma unroll
        for (int ai = 0; ai < 2; ++ai)
#pragma unroll
            for (int mp = 0; mp < 2; ++mp) {
                f32x4 old[2][2][2];
                if (!part) {
#pragma unroll
                    for (int mm = 0; mm < 2; ++mm)
#pragma unroll
                        for (int bj = 0; bj < 2; ++bj)
#pragma unroll
                            for (int n = 0; n < 2; ++n) old[mm][bj][n] = *(const f32x4*)(SRC + (size_t)(row0 + ai * 128 + (2 * mp + mm) * 16) * DM + col0 + bj * 128 + n * 16);
                }
#pragma unroll
                for (int mm = 0; mm < 2; ++mm)
#pragma unroll
                    for (int bj = 0; bj < 2; ++bj)
#pragma unroll
                        for (int n = 0; n < 2; ++n) { const int m = 2 * mp + mm; const f32x4 d = gv[bj][n] * acc[ai][bj][m][n];
                            *(f32x4*)(base + (size_t)(row0 + ai * 128 + m * 16) * DM + col0 + bj * 128 + n * 16) = part ? d : old[mm][bj][n] + d; }
            }
    }
};
struct EpiF32 {
    float* C; int ldc;
    __device__ __forceinline__ void operator()(AccRef acc, const pg8::Unit& u, int wr, int wc, int fr, int fq) const {
        const int row0 = u.pm * 256 + wr * 64 + fr, col0 = u.pn * 256 + wc * 32 + 4 * fq;
#pragma unroll
        for (int ai = 0; ai < 2; ++ai)
#pragma unroll
            for (int m = 0; m < 4; ++m) { float* rowp = C + (size_t)(row0 + ai * 128 + m * 16) * ldc + col0;
#pragma unroll
                for (int bj = 0; bj < 2; ++bj)
#pragma unroll
                    for (int n = 0; n < 2; ++n) *(f32x4*)(rowp + bj * 128 + n * 16) = acc[ai][bj][m][n]; }
    }
};
struct EpiBf16 {
    bf16_t* O; int ldc; int rope_pn; const float* cos64; const float* sin64;
    __device__ __forceinline__ void operator()(AccRef acc, const pg8::Unit& u, int wr, int wc, int fr, int fq) const {
        const int row0 = u.pm * 256 + wr * 64 + fr, col0 = u.pn * 256 + wc * 32 + 4 * fq;
        const bool rope = (u.pn == rope_pn) && (u.pm < 32);
#pragma unroll
        for (int ai = 0; ai < 2; ++ai)
#pragma unroll
            for (int m = 0; m < 4; ++m) { const int row = row0 + ai * 128 + m * 16; bf16_t* rowp = O + (size_t)row * ldc + col0;
                f32x4 cs = {1.f, 1.f, 1.f, 1.f}, sn = {0.f, 0.f, 0.f, 0.f};
                if (rope) { const int t = row & 2047; const int pos = (wc & 1) ? (t & 63) : (t >> 6); cs = *(const f32x4*)(cos64 + pos * 16 + 4 * fq); sn = *(const f32x4*)(sin64 + pos * 16 + 4 * fq); }
#pragma unroll
                for (int bj = 0; bj < 2; ++bj) {
                    const f32x4 x0 = acc[ai][bj][m][0], x1 = acc[ai][bj][m][1];
                    const f32x4 y0 = x0 * cs - x1 * sn, y1 = x1 * cs + x0 * sn;
                    u32x2 w0, w1; w0.x = cvt_pk_bf16(y0[0], y0[1]); w0.y = cvt_pk_bf16(y0[2], y0[3]); w1.x = cvt_pk_bf16(y1[0], y1[1]); w1.y = cvt_pk_bf16(y1[2], y1[3]);
                    *(u32x2*)(rowp + bj * 128) = w0; *(u32x2*)(rowp + bj * 128 + 16) = w1; } }
    }
};

#define SBAR() __builtin_amdgcn_sched_barrier(0)
template <int OFF> __device__ __forceinline__ s16x4 tr_read(int vb) {
    s16x4 r; asm volatile("ds_read_b64_tr_b16 %0, %1 offset:%2" : "=&v"(r) : "v"(vb), "i"(OFF) : "memory"); return r;
}
__device__ __forceinline__ int v_st(int k, int c) { const int kk = (k & ~0xC) | ((k & 4) << 1) | ((k & 8) >> 1); return ((kk >> 3) * 4 + (c >> 5)) * 512 + ((kk & 7) * 32 + (c & 31)) * 2; }
__device__ __forceinline__ int v_rd_base(int lane) { return ((lane & 3) << 3) | (((lane >> 2) & 3) << 6) | (((lane >> 4) & 1) << 5) | (((lane >> 5) & 1) << 8); }
constexpr int v_rd_off(int d0, int ks, int half) { return d0 * 512 + ks * 4096 + half * 2048; }
template <int D0> __device__ __forceinline__ void pv_one(f32x16& od, int vb, bf16x8 pa0, bf16x8 pa1, bf16x8 pa2, bf16x8 pa3) {
    const s16x4 l0 = tr_read<v_rd_off(D0, 0, 0)>(vb), h0 = tr_read<v_rd_off(D0, 0, 1)>(vb), l1 = tr_read<v_rd_off(D0, 1, 0)>(vb), h1 = tr_read<v_rd_off(D0, 1, 1)>(vb);
    const s16x4 l2 = tr_read<v_rd_off(D0, 2, 0)>(vb), h2 = tr_read<v_rd_off(D0, 2, 1)>(vb), l3 = tr_read<v_rd_off(D0, 3, 0)>(vb), h3 = tr_read<v_rd_off(D0, 3, 1)>(vb);
    asm volatile("s_waitcnt lgkmcnt(0)" ::: "memory"); SBAR();
#define PK(L, H) (bf16x8){L[0], L[1], L[2], L[3], H[0], H[1], H[2], H[3]}
    od = __builtin_amdgcn_mfma_f32_32x32x16_bf16(pa0, PK(l0, h0), od, 0, 0, 0);
    od = __builtin_amdgcn_mfma_f32_32x32x16_bf16(pa1, PK(l1, h1), od, 0, 0, 0);
    od = __builtin_amdgcn_mfma_f32_32x32x16_bf16(pa2, PK(l2, h2), od, 0, 0, 0);
    od = __builtin_amdgcn_mfma_f32_32x32x16_bf16(pa3, PK(l3, h3), od, 0, 0, 0);
#undef PK
}
__device__ __forceinline__ void pv_d0(f32x16* o, int vb, bf16x8 pa0, bf16x8 pa1, bf16x8 pa2, bf16x8 pa3) {
    pv_one<0>(o[0], vb, pa0, pa1, pa2, pa3); pv_one<1>(o[1], vb, pa0, pa1, pa2, pa3); pv_one<2>(o[2], vb, pa0, pa1, pa2, pa3); pv_one<3>(o[3], vb, pa0, pa1, pa2, pa3);
}
__device__ __forceinline__ void partialSM(f32x16& p0, f32x16& p1, float& m_reg, float& mn, float& alpha, const float C, const float thr_raw) {
    float pmax = p0[0];
#pragma unroll
    for (int r = 1; r < 16; ++r) pmax = fmaxf(pmax, p0[r]);
#pragma unroll
    for (int r = 0; r < 16; ++r) pmax = fmaxf(pmax, p1[r]);
    { auto rr = __builtin_amdgcn_permlane32_swap(__float_as_uint(pmax), __float_as_uint(pmax), false, false);
      pmax = fmaxf(__uint_as_float(rr[0]), __uint_as_float(rr[1])); }
    if (__builtin_expect(__all(pmax - m_reg <= thr_raw), 1)) { mn = m_reg; alpha = 1.f; }
    else { mn = fmaxf(m_reg, pmax); alpha = __builtin_amdgcn_exp2f((m_reg - mn) * C); m_reg = mn; }
    const float mnC = -mn * C;
#pragma unroll
    for (int r = 0; r < 16; ++r) p0[r] = fmaf(p0[r], C, mnC);
#pragma unroll
    for (int r = 0; r < 16; ++r) p1[r] = fmaf(p1[r], C, mnC);
#pragma unroll
    for (int r = 0; r < 16; ++r) p0[r] = __builtin_amdgcn_exp2f(p0[r]);
}
__device__ __forceinline__ void finishSM(f32x16& p0, f32x16& p1, float alpha, float& l_reg, bf16x8& pa0, bf16x8& pa1, bf16x8& pa2, bf16x8& pa3) {
#pragma unroll
    for (int r = 0; r < 16; ++r) p1[r] = __builtin_amdgcn_exp2f(p1[r]);
    float ps = 0;
#pragma unroll
    for (int r = 0; r < 16; ++r) ps += p0[r];
#pragma unroll
    for (int r = 0; r < 16; ++r) ps += p1[r];
    { auto rr = __builtin_amdgcn_permlane32_swap(__float_as_uint(ps), __float_as_uint(ps), false, false);
      ps = __uint_as_float(rr[0]) + __uint_as_float(rr[1]); }
    l_reg = l_reg * alpha + ps;
#define PK4(P, BASE, OUT) do { unsigned a0 = cvt_pk_bf16(P[BASE + 0], P[BASE + 1]), a1 = cvt_pk_bf16(P[BASE + 2], P[BASE + 3]);   \
    unsigned b0 = cvt_pk_bf16(P[BASE + 4], P[BASE + 5]), b1 = cvt_pk_bf16(P[BASE + 6], P[BASE + 7]);                              \
    auto r0 = __builtin_amdgcn_permlane32_swap(a0, b0, false, false); auto r1 = __builtin_amdgcn_permlane32_swap(a1, b1, false, false); \
    u32x4 w = {r0[0], r1[0], r0[1], r1[1]}; OUT = *reinterpret_cast<bf16x8*>(&w); } while (0)
    PK4(p0, 0, pa0); PK4(p0, 8, pa1); PK4(p1, 0, pa2); PK4(p1, 8, pa3);
#undef PK4
}
template <int DQK> __device__ __forceinline__ int kswz(int row, int colB) { return row * (DQK * 2) + (colB ^ ((row & 7) << 4)); }
template <int DQK> __device__ __forceinline__ void qkt(f32x16& p0, f32x16& p1, const char* Ks, const bf16x8* qr, int r32, int hi) {
    p0 = f32x16{}; p1 = f32x16{};
#pragma unroll
    for (int d0 = 0; d0 < DQK / 16; ++d0) { const int cb = (d0 * 16 + hi * 8) * 2;
        const bf16x8 b0 = *reinterpret_cast<const bf16x8*>(Ks + kswz<DQK>(r32, cb));
        const bf16x8 b1 = *reinterpret_cast<const bf16x8*>(Ks + kswz<DQK>(32 + r32, cb));
        p0 = __builtin_amdgcn_mfma_f32_32x32x16_bf16(b0, qr[d0], p0, 0, 0, 0);
        p1 = __builtin_amdgcn_mfma_f32_32x32x16_bf16(b1, qr[d0], p1, 0, 0, 0); }
}
template <int DQK, int SD>
__device__ __forceinline__ void attn_body(const bf16_t* __restrict__ Qb, const bf16_t* __restrict__ Kh, const bf16_t* __restrict__ Vh,
                                          bf16_t* __restrict__ Ob, const int seq, const float C, const float thr_raw, char* lds) {
    constexpr int ND0 = DQK / 16, KCH = DQK / 64  , KPR = DQK / 8  ;
    constexpr int SHM_V = 64 * 128 * 2, SHM_K = 64 * DQK * 2;
    const int tid = otid(), wid = tid >> 6, lane = tid & 63, r32 = lane & 31, hi = lane >> 5;
    char* V_lds = lds; char* K_lds = lds + 2 * SHM_V;
    float* wsl = (float*)(lds + 2 * SHM_V + 2 * SHM_K) + wid * 64; float* li_l = wsl; float* al_l = wsl + 32;
    float m_reg = -1e30f, l_reg = 0; f32x16 o[4] = {}; bf16x8 qr[ND0];
    const bf16_t* Qw = Qb + (size_t)(wid * 32 + r32) * DQK + hi * 8;
#pragma unroll
    for (int d0 = 0; d0 < ND0; ++d0) qr[d0] = *reinterpret_cast<const bf16x8*>(Qw + d0 * 16);
    const int sr = tid >> 4, sc = (tid & 15) * 8, vst0 = v_st(sr, sc), vst1 = v_st(32 + sr, sc);
    int krow[KCH], kcol[KCH];
#pragma unroll
    for (int i = 0; i < KCH; ++i) { const int cid = tid + 512 * i; krow[i] = cid / KPR; kcol[i] = (cid % KPR) * 8; }
    const int vb0 = (int)(uintptr_t)V_lds + v_rd_base(lane);
    bf16x8 svs0[SD], svs1[SD], sks[SD][KCH]; constexpr int SE = 0, SO = SD - 1;
#define SLOAD(i, k0) do { svs0[i] = *reinterpret_cast<const bf16x8*>(&Vh[(size_t)((k0) + sr) * 128 + sc]); svs1[i] = *reinterpret_cast<const bf16x8*>(&Vh[(size_t)((k0) + 32 + sr) * 128 + sc]); \
    _Pragma("unroll") for (int _c = 0; _c < KCH; ++_c) sks[i][_c] = *reinterpret_cast<const bf16x8*>(&Kh[(size_t)((k0) + krow[_c]) * DQK + kcol[_c]]); } while (0)
#define SWRITE(b, i) do { *(bf16x8*)(V_lds + (b) * SHM_V + vst0) = svs0[i]; *(bf16x8*)(V_lds + (b) * SHM_V + vst1) = svs1[i]; \
    _Pragma("unroll") for (int _c = 0; _c < KCH; ++_c) *(bf16x8*)(K_lds + (b) * SHM_K + kswz<DQK>(krow[_c], kcol[_c] * 2)) = sks[i][_c]; } while (0)
#define SWAIT() do { if constexpr (SD == 1) asm volatile("s_waitcnt vmcnt(0)" ::: "memory"); else if constexpr (KCH == 2) asm volatile("s_waitcnt vmcnt(4)" ::: "memory"); else asm volatile("s_waitcnt vmcnt(5)" ::: "memory"); } while (0)
#define RESC(a) do { if (__any((a) < 1.f)) { if (hi == 0) al_l[r32] = (a); asm volatile("s_waitcnt lgkmcnt(0)" ::: "memory"); \
    _Pragma("unroll") for (int d = 0; d < 4; ++d) _Pragma("unroll") for (int r = 0; r < 16; ++r) o[d][r] *= al_l[crow(r, hi)]; } } while (0)
    f32x16 pA0, pA1, pB0, pB1; float mnA, mnB, alA, alB; bf16x8 pa0, pa1, pa2, pa3; const int NT = seq / 64;
    SLOAD(SE, 0); asm volatile("s_waitcnt vmcnt(0)" ::: "memory"); SWRITE(0, SE); __syncthreads();
    qkt<DQK>(pA0, pA1, K_lds, qr, r32, hi); partialSM(pA0, pA1, m_reg, mnA, alA, C, thr_raw);
    SLOAD(SO, 64); if constexpr (SD == 2) { if (2 < NT) SLOAD(SE, 128); }
    SWAIT(); SWRITE(1, SO); __syncthreads();
    for (int j = 1; j + 1 < NT; j += 2) {
        SBAR(); qkt<DQK>(pB0, pB1, K_lds + SHM_K, qr, r32, hi);
        finishSM(pA0, pA1, alA, l_reg, pa0, pa1, pa2, pa3); SBAR();
        SLOAD(SO, (j + SD) * 64); SBAR();
        pv_d0(o, vb0, pa0, pa1, pa2, pa3); partialSM(pB0, pB1, m_reg, mnB, alB, C, thr_raw);
        __syncthreads(); SWAIT(); SWRITE(0, SE);
        RESC(alB); __syncthreads();
        SBAR(); qkt<DQK>(pA0, pA1, K_lds, qr, r32, hi);
        finishSM(pB0, pB1, alB, l_reg, pa0, pa1, pa2, pa3); SBAR();
        if (SD == 1 || j + 3 < NT) SLOAD(SE, (j + 1 + SD) * 64); SBAR();
        pv_d0(o, vb0 + SHM_V, pa0, pa1, pa2, pa3); partialSM(pA0, pA1, m_reg, mnA, alA, C, thr_raw);
        __syncthreads(); SWAIT(); SWRITE(1, SO);
        RESC(alA); __syncthreads();
    }
    SBAR(); qkt<DQK>(pB0, pB1, K_lds + SHM_K, qr, r32, hi);
    finishSM(pA0, pA1, alA, l_reg, pa0, pa1, pa2, pa3); SBAR();
    pv_d0(o, vb0, pa0, pa1, pa2, pa3); partialSM(pB0, pB1, m_reg, mnB, alB, C, thr_raw);
    __syncthreads(); RESC(alB);
    finishSM(pB0, pB1, alB, l_reg, pa0, pa1, pa2, pa3); SBAR();
    pv_d0(o, vb0 + SHM_V, pa0, pa1, pa2, pa3);
    if (hi == 0) li_l[r32] = l_reg; asm volatile("s_waitcnt lgkmcnt(0)" ::: "memory");
    float rli[16];
#pragma unroll
    for (int r = 0; r < 16; ++r) rli[r] = __builtin_amdgcn_rcpf(li_l[crow(r, hi)]);
    bf16_t* Ow = Ob + (size_t)(wid * 32) * DM;
#pragma unroll
    for (int r = 0; r < 16; ++r) { const int orow = crow(r, hi);
#pragma unroll
        for (int d0 = 0; d0 < 4; ++d0) Ow[(size_t)orow * DM + d0 * 32 + r32] = f2bf(o[d0][r] * rli[r]); }
#undef SLOAD
#undef SWRITE
#undef SWAIT
#undef RESC
}

template <int DQK> __device__ __forceinline__ void qkt_x(const char* qx, f32x16& p0, f32x16& p1, const char* Ks, const bf16x8* qr, int r32, int hi) {
    p0 = f32x16{}; p1 = f32x16{};
#pragma unroll
    for (int d0 = 0; d0 < DQK / 16; ++d0) { const int cb = (d0 * 16 + hi * 8) * 2;
        const bf16x8 b0 = *reinterpret_cast<const bf16x8*>(Ks + kswz<DQK>(r32, cb));
        const bf16x8 b1 = *reinterpret_cast<const bf16x8*>(Ks + kswz<DQK>(32 + r32, cb));
        const bf16x8 q = d0 < 8 ? qr[d0 < 8 ? d0 : 0] : *reinterpret_cast<const bf16x8*>(qx + (d0 - 8) * 8192);
        p0 = __builtin_amdgcn_mfma_f32_32x32x16_bf16(b0, q, p0, 0, 0, 0);
        p1 = __builtin_amdgcn_mfma_f32_32x32x16_bf16(b1, q, p1, 0, 0, 0); }
}
template <int DQK, int LDQ, int LDK, int LDV>
__device__ __forceinline__ void attn_simple(const bf16_t* __restrict__ Qb, const int qr_off, const bf16_t* __restrict__ Kn, const bf16_t* __restrict__ Kr, const bf16_t* __restrict__ Vp,
                                            const int split, const int rlat, const int rctx, bf16_t* __restrict__ Ob, const int seq, const float C, const float thr_raw, char* lds) {
    constexpr int ND0 = DQK / 16, KCH = DQK / 64;
    constexpr int SHM_V = 64 * 128 * 2, SHM_K = 64 * DQK * 2;
    const int tid = otid(), wid = __builtin_amdgcn_readfirstlane(tid >> 6), lane = tid & 63, r32 = lane & 31, hi = lane >> 5;
    char* V_lds = lds; char* K_lds = lds + 2 * SHM_V;
    LAS unsigned char* ldsl = (LAS unsigned char*)(uintptr_t)lds;
    float* wsl = (float*)(lds + 2 * SHM_V + 2 * SHM_K) + wid * 64; float* li_l = wsl; float* al_l = wsl + 32;
    float m_reg = -1e30f, l_reg = 0; f32x16 o[4] = {}; bf16x8 qr[ND0];
    const bf16_t* Qw = Qb + (size_t)(wid * 32 + r32) * LDQ + hi * 8;
#pragma unroll
    for (int d0 = 0; d0 < ND0; ++d0) qr[d0] = *reinterpret_cast<const bf16x8*>(Qw + (d0 < 8 ? d0 * 16 : qr_off + (d0 - 8) * 16));
    int voff[2], koff[KCH];
#pragma unroll
    for (int i = 0; i < 2; ++i) { const int L = (tid + 512 * i) * 16, sub = L >> 9, within = L & 511; const int kk = (sub >> 2) * 8 + (within >> 6), c = (sub & 3) * 32 + ((within & 63) >> 1);
        const int k = (kk & ~0xC) | ((kk & 4) << 1) | ((kk & 8) >> 1); voff[i] = k * LDV + c; }
#pragma unroll
    for (int i = 0; i < KCH; ++i) { const int L = (tid + 512 * i) * 16, row = L / (DQK * 2), cb = (L % (DQK * 2)) ^ ((row & 7) << 4), col = cb >> 1;
        koff[i] = (DQK == 128 || col < 128) ? row * LDK + col : -(row * 64 + col - 128) - 1; }
    const int vb0 = (int)(uintptr_t)V_lds + v_rd_base(lane);
#define STAGE(b, k0) do { const int _row0 = (k0) < split ? rlat + (k0) : rctx + (k0) - split; \
    _Pragma("unroll") for (int _i = 0; _i < 2; ++_i) __builtin_amdgcn_global_load_lds((const unsigned*)(Vp + (size_t)_row0 * LDV + voff[_i]), (LAS unsigned*)(ldsl + (b) * SHM_V + wid * 1024 + _i * 8192), 16, 0, 0); \
    _Pragma("unroll") for (int _i = 0; _i < KCH; ++_i) { const bf16_t* _g = (koff[_i] >= 0) ? Kn + (size_t)_row0 * LDK + koff[_i] : Kr + (size_t)_row0 * 64 + (-koff[_i] - 1); \
        __builtin_amdgcn_global_load_lds((const unsigned*)_g, (LAS unsigned*)(ldsl + 2 * SHM_V + (b) * SHM_K + wid * 1024 + _i * 8192), 16, 0, 0); } } while (0)
    const int NT = seq / 64;
    STAGE(0, 0); asm volatile("s_waitcnt vmcnt(0)" ::: "memory"); __syncthreads();
    for (int j = 0; j < NT; ++j) {
        const int buf = j & 1;
        if (j + 1 < NT) STAGE(buf ^ 1, (j + 1) * 64);
        f32x16 p0, p1; float mn, al; bf16x8 pa0, pa1, pa2, pa3;
        SBAR(); qkt<DQK>(p0, p1, K_lds + buf * SHM_K, qr, r32, hi);
        partialSM(p0, p1, m_reg, mn, al, C, thr_raw);
        if (__any(al < 1.f)) { if (hi == 0) al_l[r32] = al; asm volatile("s_waitcnt lgkmcnt(0)" ::: "memory");
#pragma unroll
            for (int d = 0; d < 4; ++d)
#pragma unroll
                for (int r = 0; r < 16; ++r) o[d][r] *= al_l[crow(r, hi)]; }
        finishSM(p0, p1, al, l_reg, pa0, pa1, pa2, pa3); SBAR();
        pv_d0(o, vb0 + buf * SHM_V, pa0, pa1, pa2, pa3);
        asm volatile("s_waitcnt vmcnt(0)" ::: "memory");
        __syncthreads();
    }
    if (hi == 0) li_l[r32] = l_reg; asm volatile("s_waitcnt lgkmcnt(0)" ::: "memory");
    float rli[16];
#pragma unroll
    for (int r = 0; r < 16; ++r) rli[r] = __builtin_amdgcn_rcpf(li_l[crow(r, hi)]);
    bf16_t* Ow = Ob + (size_t)(wid * 32) * DM;
#pragma unroll
    for (int r = 0; r < 16; ++r) { const int orow = crow(r, hi);
#pragma unroll
        for (int d0 = 0; d0 < 4; ++d0) Ow[(size_t)orow * DM + d0 * 32 + r32] = f2bf(o[d0][r] * rli[r]); }
#undef STAGE
}

template <int DQK, int LDQ, int LDK, int LDV>
__device__ __forceinline__ void attn_pipe(const bf16_t* __restrict__ Qb, const int qr_off, const bf16_t* __restrict__ Kn, const bf16_t* __restrict__ Kr, const bf16_t* __restrict__ Vp,
                                          const int split, const int rlat, const int rctx, bf16_t* __restrict__ Ob, const int seq, const float C, const float thr_raw, char* lds) {
    constexpr int ND0 = 8, KCH = DQK / 64;
    constexpr int SHM_V = 64 * 128 * 2, SHM_K = 64 * DQK * 2;
    const int tid = otid(), wid = __builtin_amdgcn_readfirstlane(tid >> 6), lane = tid & 63, r32 = lane & 31, hi = lane >> 5;
    char* V_lds = lds; char* K_lds = lds + 3 * SHM_V;
    LAS unsigned char* ldsl = (LAS unsigned char*)(uintptr_t)lds;
    float* wsl = (float*)(lds + 3 * SHM_V + 3 * SHM_K) + wid * 64; float* li_l = wsl; float* al_l = wsl + 32;
    char* qx_lds = lds + 3 * SHM_V + 3 * SHM_K + 2048 + tid * 16;
    float m_reg = -1e30f, l_reg = 0; f32x16 o[4] = {}; bf16x8 qr[ND0];
    const bf16_t* Qw = Qb + (size_t)(wid * 32 + r32) * LDQ + hi * 8;
#pragma unroll
    for (int d0 = 0; d0 < ND0; ++d0) qr[d0] = *reinterpret_cast<const bf16x8*>(Qw + d0 * 16);
    if constexpr (DQK == 192) {
#pragma unroll
        for (int e = 0; e < 4; ++e) *reinterpret_cast<bf16x8*>(qx_lds + e * 8192) = *reinterpret_cast<const bf16x8*>(Qw + qr_off + e * 16); }
    int voff[2], koff[KCH];
#pragma unroll
    for (int i = 0; i < 2; ++i) { const int L = (tid + 512 * i) * 16, sub = L >> 9, within = L & 511; const int kk = (sub >> 2) * 8 + (within >> 6), c = (sub & 3) * 32 + ((within & 63) >> 1);
        const int k = (kk & ~0xC) | ((kk & 4) << 1) | ((kk & 8) >> 1); voff[i] = k * LDV + c; }
#pragma unroll
    for (int i = 0; i < KCH; ++i) { const int L = (tid + 512 * i) * 16, row = L / (DQK * 2), cb = (L % (DQK * 2)) ^ ((row & 7) << 4), col = cb >> 1;
        koff[i] = (DQK == 128 || col < 128) ? row * LDK + col : -(row * 64 + col - 128) - 1; }
    const int vb0 = (int)(uintptr_t)V_lds + v_rd_base(lane);
#define STAGE(b, k0) do { const int _row0 = (k0) < split ? rlat + (k0) : rctx + (k0) - split; \
    _Pragma("unroll") for (int _i = 0; _i < 2; ++_i) __builtin_amdgcn_global_load_lds((const unsigned*)(Vp + (size_t)_row0 * LDV + voff[_i]), (LAS unsigned*)(ldsl + (b) * SHM_V + wid * 1024 + _i * 8192), 16, 0, 0); \
    _Pragma("unroll") for (int _i = 0; _i < KCH; ++_i) { const bf16_t* _g = (koff[_i] >= 0) ? Kn + (size_t)_row0 * LDK + koff[_i] : Kr + (size_t)_row0 * 64 + (-koff[_i] - 1); \
        __builtin_amdgcn_global_load_lds((const unsigned*)_g, (LAS unsigned*)(ldsl + 3 * SHM_V + (b) * SHM_K + wid * 1024 + _i * 8192), 16, 0, 0); } } while (0)
#define RESC(a) do { if (__any((a) < 1.f)) { if (hi == 0) al_l[r32] = (a); asm volatile("s_waitcnt lgkmcnt(0)" ::: "memory"); \
    _Pragma("unroll") for (int d = 0; d < 4; ++d) _Pragma("unroll") for (int r = 0; r < 16; ++r) o[d][r] *= al_l[crow(r, hi)]; } } while (0)
    f32x16 pA0, pA1, pB0, pB1; float mnA, mnB, alA, alB; bf16x8 pa0, pa1, pa2, pa3; const int NT = seq / 64;
    STAGE(0, 0); STAGE(1, 64); asm volatile("s_waitcnt vmcnt(0)" ::: "memory"); __syncthreads();
    qkt_x<DQK>(qx_lds, pA0, pA1, K_lds, qr, r32, hi); partialSM(pA0, pA1, m_reg, mnA, alA, C, thr_raw);
    STAGE(2, 128);
    int bp = 0, bc = 1, bn = 2;
    if (wid >= 4) __builtin_amdgcn_s_setprio(1);
#define HALF(c0, c1, mnc, alc, p0_, p1_, alp, j_) do { \
    SBAR(); qkt_x<DQK>(qx_lds, c0, c1, K_lds + bc * SHM_K, qr, r32, hi); \
    finishSM(p0_, p1_, alp, l_reg, pa0, pa1, pa2, pa3); SBAR(); \
    pv_d0(o, vb0 + bp * SHM_V, pa0, pa1, pa2, pa3); partialSM(c0, c1, m_reg, mnc, alc, C, thr_raw); \
    asm volatile("s_waitcnt vmcnt(0)" ::: "memory"); __syncthreads(); \
    if ((j_) + 2 < NT) STAGE(bp, ((j_) + 2) * 64); \
    RESC(alc); \
    { const int _t = bp; bp = bc; bc = bn; bn = _t; } } while (0)
    for (int j = 1; j + 1 < NT; j += 2) {
        HALF(pB0, pB1, mnB, alB, pA0, pA1, alA, j);
        HALF(pA0, pA1, mnA, alA, pB0, pB1, alB, j + 1);
    }
    SBAR(); qkt_x<DQK>(qx_lds, pB0, pB1, K_lds + bc * SHM_K, qr, r32, hi);
    finishSM(pA0, pA1, alA, l_reg, pa0, pa1, pa2, pa3); SBAR();
    pv_d0(o, vb0 + bp * SHM_V, pa0, pa1, pa2, pa3); partialSM(pB0, pB1, m_reg, mnB, alB, C, thr_raw);
    RESC(alB);
    finishSM(pB0, pB1, alB, l_reg, pa0, pa1, pa2, pa3); SBAR();
    pv_d0(o, vb0 + bc * SHM_V, pa0, pa1, pa2, pa3);
    __builtin_amdgcn_s_setprio(0);
    if (hi == 0) li_l[r32] = l_reg; asm volatile("s_waitcnt lgkmcnt(0)" ::: "memory");
    float rli[16];
#pragma unroll
    for (int r = 0; r < 16; ++r) rli[r] = __builtin_amdgcn_rcpf(li_l[crow(r, hi)]);
    bf16_t* Ow = Ob + (size_t)(wid * 32) * DM;
#pragma unroll
    for (int r = 0; r < 16; ++r) { const int orow = crow(r, hi);
#pragma unroll
        for (int d0 = 0; d0 < 4; ++d0) Ow[(size_t)orow * DM + d0 * 32 + r32] = f2bf(o[d0][r] * rli[r]); }
#undef STAGE
#undef RESC
#undef HALF
}

__device__ __forceinline__ int srccol(int type, int r) {
    if (type == 0) return r;
    if (type == 1) return r < INW ? r : -1;
    if (type == 2) { const int pn = r >> 8, rem = r & 255; const int j = 128 * pn + 64 * (rem >> 7) + 16 * ((rem >> 5) & 3) + (rem & 15); return ((rem >> 4) & 1) * FH + j; }
    return r < 512 ? 192 * (r >> 7) + (r & 127) : 192 * ((r - 512) >> 6) + 128 + ((r - 512) & 63);
}
struct TItem { const float* src; bf16_t* dst; int K, Nsrc, type, r0, k0; };
constexpr int TT_FIN = 172 * 16, TT_FOUT = 32 * 43, TT_WIN = 80 * 16, TT_WOUT = 32 * 16, TT_UQ = 12 * 4, TT_UKV = 16 * 2;
constexpr int TT_LAYER = 2 * TT_FIN + 2 * TT_FOUT + TT_WIN + TT_WOUT + TT_UQ + TT_UKV;
constexpr int N_GEMV = 288;
__device__ __forceinline__ TItem titem_decode(const Params& p, int item) {
    const int l = item / TT_LAYER; int t = item % TT_LAYER;
    TItem it; int nrt;
    unsigned char* ws = p.ws;
    if (t < TT_FIN) { it.src = p.in[6] + (size_t)l * DM * 2 * FH; it.dst = (bf16_t*)(ws + WS_W1IN + l * SZ_WFIN); it.K = DM; it.Nsrc = 2 * FH; nrt = 172; it.type = 2; }
    else if ((t -= TT_FIN) < TT_FIN) { it.src = p.in[18] + (size_t)l * DM * 2 * FH; it.dst = (bf16_t*)(ws + WS_W2IN + l * SZ_WFIN); it.K = DM; it.Nsrc = 2 * FH; nrt = 172; it.type = 2; }
    else if ((t -= TT_FIN) < TT_FOUT) { it.src = p.in[7] + (size_t)l * FH * DM; it.dst = (bf16_t*)(ws + WS_W1OUT + l * SZ_WFOUT); it.K = FH; it.Nsrc = DM; nrt = 32; it.type = 0; }
    else if ((t -= TT_FOUT) < TT_FOUT) { it.src = p.in[19] + (size_t)l * FH * DM; it.dst = (bf16_t*)(ws + WS_W2OUT + l * SZ_WFOUT); it.K = FH; it.Nsrc = DM; nrt = 32; it.type = 0; }
    else if ((t -= TT_FOUT) < TT_WIN) { it.src = p.in[8] + (size_t)l * DM * INW; it.dst = (bf16_t*)(ws + WS_WIN + l * SZ_WIN); it.K = DM; it.Nsrc = INW; nrt = 80; it.type = 1; }
    else if ((t -= TT_WIN) < TT_WOUT) { it.src = p.in[11] + (size_t)l * DM * DM; it.dst = (bf16_t*)(ws + WS_WOUT + l * SZ_WOUT); it.K = DM; it.Nsrc = DM; nrt = 32; it.type = 0; }
    else if ((t -= TT_WOUT) < TT_UQ) { it.src = p.in[9] + (size_t)l * 512 * 768; it.dst = (bf16_t*)(ws + WS_WUQ + l * SZ_WUQ); it.K = 512; it.Nsrc = 768; nrt = 12; it.type = 3; }
    else { t -= TT_UQ; it.src = p.in[10] + (size_t)l * 256 * 1024; it.dst = (bf16_t*)(ws + WS_WUKV + l * SZ_WUKV); it.K = 256; it.Nsrc = 1024; nrt = 16; it.type = 0; }
    it.r0 = (t % nrt) * 64; it.k0 = (t / nrt) * 128;
    return it;
}
__device__ __forceinline__ void titem_load(const TItem& it, int tid, f32x4 (&v)[4]) {
    const int r4 = tid & 15, kp = tid >> 4;
    const int sc = srccol(it.type, it.r0 + 4 * r4);
#pragma unroll
    for (int i = 0; i < 4; ++i) { const int kk = 64 * (i >> 1) + 2 * kp + (i & 1);
        v[i] = sc >= 0 ? __builtin_nontemporal_load((const f32x4*)(it.src + (size_t)(it.k0 + kk) * it.Nsrc + sc)) : (f32x4){0.f, 0.f, 0.f, 0.f}; }
}
__device__ __forceinline__ void titem_store(const TItem& it, int tid, const f32x4 (&v)[4], bf16_t* Tb) {
    unsigned* T = (unsigned*)Tb;
    const int r4 = tid & 15, kp = tid >> 4;
#pragma unroll
    for (int h = 0; h < 2; ++h)
#pragma unroll
        for (int j = 0; j < 4; ++j) T[(4 * r4 + j) * 65 + 32 * h + kp] = cvt_pk_bf16(v[2 * h][j], v[2 * h + 1][j]);
    __syncthreads();
#pragma unroll
    for (int i = 0; i < 2; ++i) { const int c = tid + 512 * i, row = c >> 4, k8 = (c & 15) * 8;
        const unsigned* tp = T + row * 65 + 4 * (c & 15);
        const u32x4 w = {tp[0], tp[1], tp[2], tp[3]};
        *(u32x4*)(it.dst + (size_t)(it.r0 + row) * it.K + it.k0 + k8) = w; }
}
__device__ __forceinline__ int tset_item(int l, int which, int i) {
    if (which == 0) return l * TT_LAYER + 2 * TT_FIN + 2 * TT_FOUT + i;
    const int bin = (which == 1) ? 0 : TT_FIN, bout = 2 * TT_FIN + ((which == 1) ? 0 : TT_FOUT);
    return l * TT_LAYER + (i < TT_FIN ? bin + i : bout + i - TT_FIN);
}
__device__ __forceinline__ void transpose_set(const Params& p, int l, int which, int start0, int stride, char* lds, int lo4 = 0, int hi4 = 4) {
    const int nall = (which == 0) ? TT_WIN + TT_WOUT + TT_UQ + TT_UKV : TT_FIN + TT_FOUT;
    const int n = (nall * hi4) / 4, start = (nall * lo4) / 4 + start0;
    const int tid = otid();
    if (start >= n) return;
    TItem c0 = titem_decode(p, tset_item(l, which, start)), c1 = c0;
    f32x4 v0[4], v1[4], v2[4];
    titem_load(c0, tid, v0);
    if (start + stride < n) { c1 = titem_decode(p, tset_item(l, which, start + stride)); titem_load(c1, tid, v1); }
    int buf = 0;
    for (int i = start; i < n; i += stride) {
        TItem c2 = c1;
        if (i + 2 * stride < n) { c2 = titem_decode(p, tset_item(l, which, i + 2 * stride)); titem_load(c2, tid, v2); }
        titem_store(c0, tid, v0, (bf16_t*)(lds + buf * 17408));
        buf ^= 1; c0 = c1; c1 = c2;
#pragma unroll
        for (int q = 0; q < 4; ++q) { v0[q] = v1[q]; v1[q] = v2[q]; }
    }
    __syncthreads();
}
__device__ __forceinline__ void gemv_item(const Params& p, int job, char* lds, bool first) {
    const int l = job / 144, cb = job % 144;
    const int tid = otid();
    float* sc = (float*)lds;
    float* red = (float*)(lds + 40960);
    if (first) {
        for (int e = tid; e < 5 * DM; e += 512) { const int v = e >> 11, kk = e & 2047;
            const float c = v < 4 ? p.in[1][v * DM + kk] : p.in[3][kk];
            sc[e] = c * __builtin_amdgcn_rcpf(1.f + __builtin_amdgcn_exp2f(-c * LOG2E)); }
        __syncthreads();
    }
    const int c4 = tid & 31, ksub = tid >> 5;
    const float* wp = p.in[4] + ((size_t)l * DM + ksub * 128) * MODW + cb * 128 + c4 * 4;
    f32x4 acc[5];
#pragma unroll
    for (int v = 0; v < 5; ++v) acc[v] = (f32x4){0.f, 0.f, 0.f, 0.f};
#pragma unroll 1
    for (int i0 = 0; i0 < 128; i0 += 8) {
        f32x4 w[8];
#pragma unroll
        for (int i = 0; i < 8; ++i) w[i] = __builtin_nontemporal_load((const f32x4*)(wp + (size_t)(i0 + i) * MODW));
#pragma unroll
        for (int i = 0; i < 8; ++i)
#pragma unroll
            for (int v = 0; v < 5; ++v) acc[v] += w[i] * sc[v * DM + ksub * 128 + i0 + i];
    }
#pragma unroll
    for (int v = 0; v < 5; ++v) *(f32x4*)(red + (ksub * 5 + v) * 128 + c4 * 4) = acc[v];
    __syncthreads();
    float* M = (float*)(p.ws + WS_MOD) + (size_t)l * 5 * MODW + cb * 128;
    for (int e = tid; e < 640; e += 512) { const int v = e >> 7, cc = e & 127;
        float sacc = p.in[5][l * MODW + cb * 128 + cc];
#pragma unroll
        for (int ks = 0; ks < 16; ++ks) sacc += red[(ks * 5 + v) * 128 + cc];
        M[(size_t)v * MODW + cc] = sacc; }
    __syncthreads();
}
__device__ __forceinline__ void sincos_acc(double a, float& s, float& c) {
    const double k = rint(a * 0.63661977236758134308);
    double r = fma(-k, 1.57079632679489655800e+00, a); r = fma(-k, 6.12323399573676603587e-17, r);
    const double r2 = r * r;
    double sp = r * (1.0 + r2 * (-1.0 / 6 + r2 * (1.0 / 120 + r2 * (-1.0 / 5040 + r2 * (1.0 / 362880 + r2 * (-1.0 / 39916800 + r2 * (1.0 / 6227020800.0)))))));
    double cp = 1.0 + r2 * (-0.5 + r2 * (1.0 / 24 + r2 * (-1.0 / 720 + r2 * (1.0 / 40320 + r2 * (-1.0 / 3628800 + r2 * (1.0 / 479001600 + r2 * (-1.0 / 87178291200.0)))))));
    const int q = ((int)k) & 3;
    const double ss = (q == 0) ? sp : (q == 1) ? cp : (q == 2) ? -sp : -cp;
    const double cc = (q == 0) ? cp : (q == 1) ? -sp : (q == 2) ? -cp : sp;
    s = (float)ss; c = (float)cc;
}
__device__ __forceinline__ void rope_tables(const Params& p) {
    float* tab = (float*)(p.ws + WS_ROPE);
    for (int e = otid(); e < 3072; e += 512) {
        int pos, l; double base; float *cp, *sp;
        if (e < 2048) { pos = e >> 5; l = e & 31; base = 0.7498942093324559; cp = tab + e; sp = tab + 2048 + e; }
        else { const int f = e - 2048; pos = f >> 4; l = f & 15; base = 0.5623413251903491; cp = tab + 4096 + f; sp = tab + 5120 + f; }
        double fr = 1.0; for (int i = 0; i < l; ++i) fr *= base;
        const float ang = (float)pos * (float)fr;
        float s, c; sincos_acc((double)ang, s, c); *cp = c; *sp = s;
    }
}

__device__ __forceinline__ void norm_phase(float* __restrict__ X, bf16_t* __restrict__ H, const float* __restrict__ modl, int shiftIdx, int scaleIdx, int nrows, const float* __restrict__ PART, const float* __restrict__ XLAT) {
    const int tid_ = otid(); const int lane = tid_ & 63, gw = blockIdx.x * 8 + (tid_ >> 6), nw = gridDim.x * 8;
    for (int row = gw; row < nrows; row += nw) {
        float* xr = X + (size_t)row * DM;
        const float* xs = (XLAT != nullptr && row < NLAT) ? XLAT + (size_t)row * DM : xr;
        f32x4 x[8]; float ss = 0.f;
#pragma unroll
        for (int i = 0; i < 8; ++i) x[i] = *(const f32x4*)(xs + (i * 64 + lane) * 4);
        if (PART != nullptr && row >= NLAT) {
#pragma unroll
            for (int s = 0; s < 8; ++s) { f32x4 pt[8];
#pragma unroll
                for (int i = 0; i < 8; ++i) pt[i] = *(const f32x4*)(PART + ((size_t)s * NCTX + (row - NLAT)) * DM + (i * 64 + lane) * 4);
#pragma unroll
                for (int i = 0; i < 8; ++i) x[i] += pt[i]; }
#pragma unroll
            for (int i = 0; i < 8; ++i) *(f32x4*)(xr + (i * 64 + lane) * 4) = x[i];
        }
#pragma unroll
        for (int i = 0; i < 8; ++i) ss += x[i][0] * x[i][0] + x[i][1] * x[i][1] + x[i][2] * x[i][2] + x[i][3] * x[i][3];
        ss = wave_sum(ss);
        const float r = rsqrtf(ss * (1.f / DM) + EPS);
        const int v = row < NLAT ? (row >> 11) : 4;
        const float* sh = modl + (size_t)v * MODW + shiftIdx * DM; const float* scl = modl + (size_t)v * MODW + scaleIdx * DM;
#pragma unroll
        for (int i = 0; i < 8; ++i) { const int c = (i * 64 + lane) * 4; const f32x4 s4 = *(const f32x4*)(sh + c), c4 = *(const f32x4*)(scl + c);
            const f32x4 h = x[i] * r * (c4 + 1.f) + s4;
            u32x2 w; w.x = cvt_pk_bf16(h[0], h[1]); w.y = cvt_pk_bf16(h[2], h[3]);
            *(u32x2*)(H + (size_t)row * DM + c) = w; }
    }
}
__device__ __forceinline__ void final_phase(const float* __restrict__ X, float* __restrict__ out, const float* __restrict__ gain) {
    const int tid_ = otid(); const int lane = tid_ & 63, gw = blockIdx.x * 8 + (tid_ >> 6), nw = gridDim.x * 8;
    for (int row = gw; row < NLAT; row += nw) {
        const float* xr = X + (size_t)row * DM;
        f32x4 x[8]; float ss = 0.f;
#pragma unroll
        for (int i = 0; i < 8; ++i) { x[i] = *(const f32x4*)(xr + (i * 64 + lane) * 4); ss += x[i][0] * x[i][0] + x[i][1] * x[i][1] + x[i][2] * x[i][2] + x[i][3] * x[i][3]; }
        ss = wave_sum(ss);
        const float r = rsqrtf(ss * (1.f / DM) + EPS);
#pragma unroll
        for (int i = 0; i < 8; ++i) { const int c = (i * 64 + lane) * 4; *(f32x4*)(out + (size_t)row * DM + c) = x[i] * r * *(const f32x4*)(gain + c); }
    }
}
__device__ __forceinline__ void prep_phase(const Params& p, int l) {
    unsigned char* ws = p.ws;
    const bf16_t* P = (const bf16_t*)(ws + WS_GP);
    const float* qg = p.in[12] + l * 128; const float* kg = p.in[13] + l * 128; const float* mqg = p.in[14] + l * 512; const float* mkvg = p.in[15] + l * 256;
    const float* tab = (const float*)(ws + WS_ROPE); const float* cos128 = tab; const float* sin128 = tab + 2048; const float* cos64 = tab + 4096; const float* sin64 = tab + 5120;
    bf16_t* QA = (bf16_t*)(ws + WS_QA); bf16_t* KA = (bf16_t*)(ws + WS_KA); bf16_t* VA = (bf16_t*)(ws + WS_VA);
    bf16_t* CQN = (bf16_t*)(ws + WS_CQN); bf16_t* CKVN = (bf16_t*)(ws + WS_CKVN); bf16_t* KRb = (bf16_t*)(ws + WS_KR);
    const int tid_ = otid(); const int lane = tid_ & 63, gw = blockIdx.x * 8 + (tid_ >> 6), nw = gridDim.x * 8;
    const int half = lane >> 5, li = lane & 31;
    float gq_[4], gk_[4];
#pragma unroll
    for (int q = 0; q < 4; ++q) { gq_[q] = qg[q * 32 + li]; gk_[q] = kg[q * 32 + li]; }
    const f32x4 g0 = *(const f32x4*)(mqg + 4 * lane), g1 = *(const f32x4*)(mqg + 256 + 4 * lane), gkv = *(const f32x4*)(mkvg + 4 * lane);
    for (int row = gw; row < NTOK; row += nw) {
        const bf16_t* pr = P + (size_t)row * INWP;
        const bool lat = row < NLAT; int b, t, pos;
        if (lat) { b = row >> 11; t = row & 2047; pos = t; } else { const int rr = row - NLAT; b = rr >> 8; t = rr & 255; pos = SEQ + t; }
        const int grow = lat ? (t >> 6) : 0, gcol = lat ? (t & 63) : 0;
        float xh[5][4];
#pragma unroll
        for (int it = 0; it < 5; ++it) { const bf16_t* xp = pr + (it < 4 ? PC_GQ + (2 * it + half) * 128 : PC_GK + half * 128) + li;
#pragma unroll
            for (int q = 0; q < 4; ++q) xh[it][q] = bf2f(xp[q * 32]); }
        const u32x2 v4 = *(const u32x2*)(pr + PC_GV + 4 * lane);
        const f32x4 a0 = bf4_to_f4(*(const u32x2*)(pr + PC_CQ + 4 * lane)), a1 = bf4_to_f4(*(const u32x2*)(pr + PC_CQ + 256 + 4 * lane));
        const f32x4 c0 = bf4_to_f4(*(const u32x2*)(pr + PC_CKV + 4 * lane));
        float xr_[4];
#pragma unroll
        for (int q = 0; q < 4; ++q) xr_[q] = bf2f(pr[PC_KR + q * 16 + (lane & 15)]);
        const float cr = cos128[grow * 32 + li], sr = sin128[grow * 32 + li], cc = cos128[gcol * 32 + li], sn = sin128[gcol * 32 + li];
        const float kc0 = cos64[grow * 16 + (lane & 15)], ks0 = sin64[grow * 16 + (lane & 15)], kc1 = cos64[gcol * 16 + (lane & 15)], ks1 = sin64[gcol * 16 + (lane & 15)];
#pragma unroll
        for (int it = 0; it < 5; ++it) {
            const bool isq = it < 4; const int head = isq ? 2 * it + half : half;
            float x0 = xh[it][0], x1 = xh[it][1], x2 = xh[it][2], x3 = xh[it][3];
            const float ss = half_sum(x0 * x0 + x1 * x1 + x2 * x2 + x3 * x3);
            const float r = rsqrtf(ss * (1.f / 128) + EPS);
            x0 *= r * (isq ? gq_[0] : gk_[0]); x1 *= r * (isq ? gq_[1] : gk_[1]); x2 *= r * (isq ? gq_[2] : gk_[2]); x3 *= r * (isq ? gq_[3] : gk_[3]);
            float y0 = x0, y1 = x1, y2 = x2, y3 = x3;
            if (lat) { y0 = x0 * cr - x1 * sr; y1 = x1 * cr + x0 * sr; y2 = x2 * cc - x3 * sn; y3 = x3 * cc + x2 * sn; }
            bf16_t* dp;
            if (isq) dp = lat ? QA + ((size_t)(b * 8 + head) * SEQ + t) * 128 : QA + (size_t)NLAT * 1024 + ((size_t)(b * 8 + head) * CTXL + t) * 128;
            else dp = KA + ((size_t)(b * 2 + head) * SKV + pos) * 128;
            dp[li] = f2bf(y0); dp[32 + li] = f2bf(y1); dp[64 + li] = f2bf(y2); dp[96 + li] = f2bf(y3);
        }
        *(u32x2*)(VA + ((size_t)(b * 2 + (lane >> 5)) * SKV + pos) * 128 + ((4 * lane) & 127)) = v4;
        { float ss = a0[0] * a0[0] + a0[1] * a0[1] + a0[2] * a0[2] + a0[3] * a0[3] + a1[0] * a1[0] + a1[1] * a1[1] + a1[2] * a1[2] + a1[3] * a1[3];
          ss = wave_sum(ss); const float r = rsqrtf(ss * (1.f / 512) + EPS);
          const f32x4 y0 = a0 * r * g0, y1 = a1 * r * g1; u32x2 w0, w1;
          w0.x = cvt_pk_bf16(y0[0], y0[1]); w0.y = cvt_pk_bf16(y0[2], y0[3]); w1.x = cvt_pk_bf16(y1[0], y1[1]); w1.y = cvt_pk_bf16(y1[2], y1[3]);
          *(u32x2*)(CQN + (size_t)row * 512 + 4 * lane) = w0; *(u32x2*)(CQN + (size_t)row * 512 + 256 + 4 * lane) = w1; }
        { float ss = c0[0] * c0[0] + c0[1] * c0[1] + c0[2] * c0[2] + c0[3] * c0[3];
          ss = wave_sum(ss); const float r = rsqrtf(ss * (1.f / 256) + EPS);
          const f32x4 y0 = c0 * r * gkv; u32x2 w0; w0.x = cvt_pk_bf16(y0[0], y0[1]); w0.y = cvt_pk_bf16(y0[2], y0[3]);
          *(u32x2*)(CKVN + (size_t)row * 256 + 4 * lane) = w0; }
        if (lane < 16) {
            const float x0 = xr_[0], x1 = xr_[1], x2 = xr_[2], x3 = xr_[3];
            float y0 = x0, y1 = x1, y2 = x2, y3 = x3;
            if (lat) { y0 = x0 * kc0 - x1 * ks0; y1 = x1 * kc0 + x0 * ks0; y2 = x2 * kc1 - x3 * ks1; y3 = x3 * kc1 + x2 * ks1; }
            bf16_t* dp = KRb + (size_t)row * 64 + lane; dp[0] = f2bf(y0); dp[16] = f2bf(y1); dp[32] = f2bf(y2); dp[48] = f2bf(y3);
        }
    }
}

__device__ __forceinline__ int hgrn_row(int b, int dir, int ppos) {
    if (dir == 0) return ppos < CTXL ? NLAT + b * CTXL + ppos : b * SEQ + (ppos - CTXL);
    return ppos < CTXL ? NLAT + b * CTXL + (CTXL - 1 - ppos) : b * SEQ + (SEQ - 1 - (ppos - CTXL));
}
constexpr int H1_QS = 0, H1_KD = 17408, H1_KO = 34816, H1_VT = 60928, H1_KET = 79360, H1_AS = 97792, H1_TOT = 107008;
__device__ __forceinline__ void hgrn_chunk_job(const Params& p, int l, int job, char* lds) {
    unsigned char* ws = p.ws;
    const bf16_t* P = (const bf16_t*)(ws + WS_GP);
    const int c = job % NCHUNK, chain = job / NCHUNK, dir = chain & 1, h = (chain >> 1) & 3, b = chain >> 3;
    bf16_t* Qs = (bf16_t*)(lds + H1_QS); bf16_t* Kd = (bf16_t*)(lds + H1_KD); bf16_t* Ko = (bf16_t*)(lds + H1_KO);
    bf16_t* VT = (bf16_t*)(lds + H1_VT); bf16_t* KeT = (bf16_t*)(lds + H1_KET); bf16_t* AS = (bf16_t*)(lds + H1_AS);
    float* tot = (float*)(lds + H1_TOT);
    const int tid = otid(), lane = tid & 63, wid = tid >> 6;
    const int kch = tid & 127, seg = __builtin_amdgcn_readfirstlane(tid >> 7);
    const int p0 = c * 64;
    const int rstep = dir == 0 ? 1 : -1;
    const int rowbase = dir == 0 ? (p0 < CTXL ? NLAT + b * CTXL + p0 : b * SEQ + (p0 - CTXL)) : (p0 < CTXL ? NLAT + b * CTXL + (CTXL - 1 - p0) : b * SEQ + (SEQ - 1 - (p0 - CTXL)));
    float lb = 0.f;
    if (l == 1) { const float a0 = p.in[16][(dir * 2 + 0) * 512 + h * 128 + kch], a1 = p.in[16][(dir * 2 + 1) * 512 + h * 128 + kch]; lb = 1.f / (1.f + expf(a0 - a1)); }
    const int zcol = (dir ? PC_HB : PC_HF) + h * 128 + kch;
    float loc[16], kk[16], qv[16]; float run = 0.f;
    float zin[16], qin[16], vin[16];
#pragma unroll
    for (int j = 0; j < 16; ++j) { const int row = rowbase + rstep * (16 * seg + j);
        const bf16_t* pr = P + (size_t)row * INWP;
        zin[j] = bf2f(pr[zcol]); qin[j] = bf2f(pr[PC_HQ + h * 128 + kch]); vin[j] = bf2f(pr[PC_HI + h * 128 + kch]); }
#pragma unroll
    for (int j = 0; j < 16; ++j) { const int i = 16 * seg + j;
        const float z = zin[j], q = qin[j], vv = vin[j];
        const float e = __builtin_amdgcn_exp2f(-fabsf(z) * LOG2E);
        const float rinv = __builtin_amdgcn_rcpf(1.f + e);
        const float sg = (z >= 0.f ? 1.f : e) * rinv, sgn = (z >= 0.f ? e : 1.f) * rinv;
        float lf2;
        if (l == 0) lf2 = fminf(z, 0.f) * LOG2E - __builtin_amdgcn_logf(1.f + e); else lf2 = __builtin_amdgcn_logf(lb + (1.f - lb) * sg);
        run += lf2; loc[j] = run; kk[j] = (1.f - lb) * sgn; qv[j] = q * 0.08838834764831845f;
        VT[kch * 72 + i] = f2bf(vv); }
    tot[seg * 128 + kch] = run;
    __syncthreads();
    const float t0 = tot[kch], t1 = tot[128 + kch], t2 = tot[256 + kch], t3 = tot[384 + kch];
    const float bseg = (seg > 0 ? t0 : 0.f) + (seg > 1 ? t1 : 0.f) + (seg > 2 ? t2 : 0.f);
    const float after = (seg < 1 ? t1 : 0.f) + (seg < 2 ? t2 : 0.f) + (seg < 3 ? t3 : 0.f);
    bf16_t* qe = (bf16_t*)(ws + WS_QE) + ((size_t)(chain * NCHUNK + c)) * 8192;
#pragma unroll
    for (int j = 0; j < 16; ++j) { const int i = 16 * seg + j;
        Qs[i * 136 + kch] = f2bf(qv[j] * __builtin_amdgcn_exp2f(loc[j]));
        Kd[i * 136 + kch] = f2bf(kk[j] * __builtin_amdgcn_exp2f(-loc[j]));
        KeT[kch * 72 + i] = f2bf(kk[j] * __builtin_amdgcn_exp2f(run - loc[j] + after));
        qe[i * 128 + kch] = f2bf(qv[j] * __builtin_amdgcn_exp2f(bseg + loc[j])); }
    if (seg == 0) ((float*)(ws + WS_DEC))[(size_t)(chain * NCHUNK + c) * 128 + kch] = __builtin_amdgcn_exp2f(t0 + t1 + t2 + t3);
    { float between = 0.f;
#pragma unroll
      for (int ii = 1; ii < 4; ++ii) if (ii > seg) { const int base = (ii == 1) ? 0 : (ii == 2 ? 16 : 48);
#pragma unroll
          for (int j = 0; j < 16; ++j) Ko[(base + 16 * seg + j) * 136 + kch] = f2bf(kk[j] * __builtin_amdgcn_exp2f(run - loc[j] + between));
          between += (ii == 1) ? t1 : (ii == 2 ? t2 : t3); } }
    __syncthreads();
    { const int fr = lane & 15, fq = lane >> 4;
#pragma unroll
      for (int rep = 0; rep < 2; ++rep) { const int blk = wid + 8 * rep; if (blk < 10) {
          const int i = blk < 1 ? 0 : (blk < 3 ? 1 : (blk < 6 ? 2 : 3)); const int j = blk - (i * (i + 1)) / 2;
          const bf16_t* Ap = Qs + (16 * i + fr) * 136 + 8 * fq;
          const bf16_t* Bp = (j == i) ? Kd + (16 * i + fr) * 136 + 8 * fq : Ko + (((i == 1) ? 0 : (i == 2 ? 16 : 48)) + 16 * j + fr) * 136 + 8 * fq;
          f32x4 sc = {0.f, 0.f, 0.f, 0.f};
#pragma unroll
          for (int ks = 0; ks < 4; ++ks) sc = __builtin_amdgcn_mfma_f32_16x16x32_bf16(*(const bf16x8*)(Ap + 32 * ks), *(const bf16x8*)(Bp + 32 * ks), sc, 0, 0, 0);
#pragma unroll
          for (int r = 0; r < 4; ++r) { const int tl = 4 * fq + r;
              AS[(16 * i + tl) * 72 + 16 * j + fr] = f2bf((j < i || fr <= tl) ? sc[r] : 0.f);
              if (j < i) AS[(16 * j + tl) * 72 + 16 * i + fr] = 0; } } } }
    __syncthreads();
    const int r32 = lane & 31, hi = lane >> 5;
    { const int vb = wid >> 1; f32x16 u0 = {}, u1 = {}; const int kb0 = (wid & 1) * 2;
#pragma unroll
      for (int ks = 0; ks < 4; ++ks) {
          const bf16x8 a = *(const bf16x8*)(VT + (32 * vb + r32) * 72 + 16 * ks + 8 * hi);
          const bf16x8 b0 = *(const bf16x8*)(KeT + (32 * kb0 + r32) * 72 + 16 * ks + 8 * hi);
          const bf16x8 b1 = *(const bf16x8*)(KeT + (32 * (kb0 + 1) + r32) * 72 + 16 * ks + 8 * hi);
          u0 = __builtin_amdgcn_mfma_f32_32x32x16_bf16(a, b0, u0, 0, 0, 0);
          u1 = __builtin_amdgcn_mfma_f32_32x32x16_bf16(a, b1, u1, 0, 0, 0); }
      float* st = (float*)(ws + WS_ST) + ((size_t)(chain * NCHUNK + c)) * 16384;
#pragma unroll
      for (int r = 0; r < 16; ++r) { const int v = 32 * vb + crow(r, hi); st[v * 128 + 32 * kb0 + r32] = u0[r]; st[v * 128 + 32 * (kb0 + 1) + r32] = u1[r]; } }
    { const int tb = wid >> 2, vb = wid & 3; f32x16 oo = {};
#pragma unroll
      for (int ks = 0; ks < 4; ++ks) {
          const bf16x8 a = *(const bf16x8*)(AS + (32 * tb + r32) * 72 + 16 * ks + 8 * hi);
          const bf16x8 bb = *(const bf16x8*)(VT + (32 * vb + r32) * 72 + 16 * ks + 8 * hi);
          oo = __builtin_amdgcn_mfma_f32_32x32x16_bf16(a, bb, oo, 0, 0, 0); }
      float* oi = (float*)(ws + WS_OI) + (size_t)dir * NTOK * 512;
#pragma unroll
      for (int r = 0; r < 16; ++r) { const int t = 32 * tb + crow(r, hi); const int row = rowbase + rstep * t;
          oi[(size_t)row * 512 + h * 128 + 32 * vb + r32] = oo[r]; } }
    __syncthreads();
}
__device__ __forceinline__ void hgrn_scan_phase(const Params& p) {
    const float* __restrict__ U = (const float*)(p.ws + WS_ST); bf16_t* __restrict__ S2 = (bf16_t*)(p.ws + WS_ST2); const float* __restrict__ DEC = (const float*)(p.ws + WS_DEC);
    const int nthr = gridDim.x * 512;
    for (int e = blockIdx.x * 512 + otid(); e < NCHAIN * 4096; e += nthr) {
        const int chain = e >> 12, idx4 = (e & 4095) * 4, k4 = idx4 & 127;
        const float* up = U + (size_t)chain * NCHUNK * 16384 + idx4; bf16_t* sp = S2 + (size_t)chain * NCHUNK * 16384 + idx4; const float* dp = DEC + (size_t)chain * NCHUNK * 128 + k4;
        f32x4 S = {0.f, 0.f, 0.f, 0.f};
#pragma unroll 1
        for (int c0 = 0; c0 < NCHUNK; c0 += 12) {
            f32x4 u[12], d[12];
#pragma unroll
            for (int j = 0; j < 12; ++j) { u[j] = __builtin_nontemporal_load((const f32x4*)(up + (size_t)(c0 + j) * 16384)); d[j] = *(const f32x4*)(dp + (c0 + j) * 128); }
#pragma unroll
            for (int j = 0; j < 12; ++j) { u32x2 w; w.x = cvt_pk_bf16(S[0], S[1]); w.y = cvt_pk_bf16(S[2], S[3]);
                *(u32x2*)(sp + (size_t)(c0 + j) * 16384) = w;
                S = d[j] * S + u[j]; }
        }
    }
}
__device__ __forceinline__ void hgrn_out_job(const Params& p, int l, int job, char* lds) {
    unsigned char* ws = p.ws;
    const int j = job % NCHUNK, h = (job / NCHUNK) & 3, b = job / (NCHUNK * 4);
    const int tid = otid(), lane = tid & 63, wid = tid >> 6, r32 = lane & 31, hi = lane >> 5;
    const int tb = wid >> 2, vb = wid & 3;
    const int row0 = j < 4 ? NLAT + b * CTXL + 64 * j : b * SEQ + 64 * (j - 4);
    const float* oi0 = (const float*)(ws + WS_OI); const float* oi1 = oi0 + (size_t)NTOK * 512;
    const bf16_t* P = (const bf16_t*)(ws + WS_GP);
    const int col = h * 128 + 32 * vb + r32;
    float oiv[16], gv[16];
#pragma unroll
    for (int r = 0; r < 16; ++r) { const int row = row0 + 32 * tb + crow(r, hi);
        oiv[r] = oi0[(size_t)row * 512 + col] + oi1[(size_t)row * 512 + col]; gv[r] = bf2f(P[(size_t)row * INWP + PC_HG + col]); }
    f32x16 acc = {};
#pragma unroll
    for (int dir = 0; dir < 2; ++dir) {
        const int chain = (b * 4 + h) * 2 + dir; const int c = dir == 0 ? j : (j < 4 ? 3 - j : 39 - j);
        const bf16_t* qe = (const bf16_t*)(ws + WS_QE) + ((size_t)(chain * NCHUNK + c)) * 8192;
        const bf16_t* st = (const bf16_t*)(ws + WS_ST2) + ((size_t)(chain * NCHUNK + c)) * 16384;
        const int o = 32 * tb + r32; const int i = dir == 0 ? o : 63 - o;
        bf16x8 a[8], bq[8];
#pragma unroll
        for (int ks = 0; ks < 8; ++ks) { a[ks] = *(const bf16x8*)(qe + i * 128 + 16 * ks + 8 * hi); bq[ks] = *(const bf16x8*)(st + (32 * vb + r32) * 128 + 16 * ks + 8 * hi); }
#pragma unroll
        for (int ks = 0; ks < 8; ++ks) acc = __builtin_amdgcn_mfma_f32_32x32x16_bf16(a[ks], bq[ks], acc, 0, 0, 0);
    }
    float* part = (float*)lds;
    float ov[16];
#pragma unroll
    for (int r = 0; r < 16; ++r) { ov[r] = acc[r] + oiv[r];
        const float ssq = half_sum(ov[r] * ov[r]);
        if (r32 == 0) part[vb * 64 + 32 * tb + crow(r, hi)] = ssq; }
    __syncthreads();
    const float gn = p.in[17][l * 128 + 32 * vb + r32];
    bf16_t* MIX = (bf16_t*)(ws + WS_MIX);
#pragma unroll
    for (int r = 0; r < 16; ++r) { const int tr = 32 * tb + crow(r, hi); const int row = row0 + tr;
        const float tot = part[tr] + part[64 + tr] + part[128 + tr] + part[192 + tr];
        const float g = gv[r];
        const float y = ov[r] * rsqrtf(tot * (1.f / 128) + EPS) * gn * g * __builtin_amdgcn_rcpf(1.f + __builtin_amdgcn_exp2f(-g * LOG2E));
        MIX[(size_t)row * DM + 1024 + col] = f2bf(y); }
    __syncthreads();
}

__device__ __forceinline__ void mixer_queue_phase(const Params& p, int l, char* lds) {
    unsigned char* ws = p.ws;
    unsigned* ctr = (unsigned*)(ws + WS_CTRL) + 16 * (l + 1);
    const bool need_ctx = (l == 0);
    const int nH3 = 16 * NCHUNK, total = 384 + nH3 + (need_ctx ? 48 : 0);
    volatile int* slot = (volatile int*)(lds + LDS_ITEM_OFF);
    bf16_t* MIX = (bf16_t*)(ws + WS_MIX);
    const bf16_t* QA = (const bf16_t*)(ws + WS_QA); const bf16_t* KA = (const bf16_t*)(ws + WS_KA); const bf16_t* VA = (const bf16_t*)(ws + WS_VA);
    const bf16_t* UQ = (const bf16_t*)(ws + WS_UQ); const bf16_t* UKV = (const bf16_t*)(ws + WS_UKV); const bf16_t* KR = (const bf16_t*)(ws + WS_KR);
    const float C_A = 0.08838834764831845f * LOG2E, THR_A = 8.f / 0.08838834764831845f;
    const float C_M = 0.07216878364870323f * LOG2E, THR_M = 8.f / 0.07216878364870323f;
    for (;;) {
        if (threadIdx.x == 0) *slot = (int)atomicAdd(ctr, 1u);
        __syncthreads();
        const int item = *slot;
        __syncthreads();
        if (item >= total) break;
        const int nb = 384 + nH3;
        if (item < 128 || item >= nb + 32) {
            const bool isl = item < 128; const int q = isl ? item : item - nb - 32;
            const int b = isl ? q >> 5 : q >> 2, h = isl ? (q >> 3) & 3 : q & 3, qb = isl ? q & 7 : 0;
            const int qrow0 = isl ? b * SEQ + qb * 256 : NLAT + b * CTXL;
            attn_pipe<192, 768, 1024, 1024>(UQ + (size_t)qrow0 * 768 + h * 128, 512 + h * 64 - h * 128, UKV + h * 256, KR, UKV + h * 256 + 128,
                                              isl ? SEQ : 0, b * SEQ, NLAT + b * CTXL, MIX + (size_t)qrow0 * DM + 1536 + h * 128, isl ? SKV : CTXL, C_M, THR_M, lds);
        } else if (item < 384 || item >= nb) {
            const bool isl = item < 384; const int q = isl ? item - 128 : item - nb;
            const int b = isl ? q >> 6 : q >> 3, h = isl ? (q >> 3) & 7 : q & 7, qb = isl ? q & 7 : 0, kvh = h >> 2;
            const bf16_t* Qp = isl ? QA + ((size_t)(b * 8 + h) * SEQ + qb * 256) * 128 : QA + (size_t)NLAT * 1024 + (size_t)(b * 8 + h) * CTXL * 128;
            const int kr0 = (b * 2 + kvh) * SKV;
            bf16_t* Op = MIX + (size_t)(isl ? b * SEQ + qb * 256 : NLAT + b * CTXL) * DM + h * 128;
            attn_pipe<128, 128, 128, 128>(Qp, 0, KA, KA, VA, isl ? SEQ : 0, kr0, kr0 + SEQ, Op, isl ? SKV : CTXL, C_A, THR_A, lds);
        } else {
            const int q = item - 384, bh = q / NCHUNK, jj = q % NCHUNK;
            if (need_ctx || jj >= 4) hgrn_out_job(p, l, bh * NCHUNK + jj, lds);
        }
        __syncthreads();
    }
}

#define XB_TMO      128
#define XB_XCNT(j)  (256  + 64 * (j))
#define XB_XSUB(j)  (1280 + 64 * (j))
#define XB_XGEN(j)  (2304 + 64 * (j))
#define XB_TOP      3328
#define XB_TOPGEN   3392
#define XCD_BAR_WORDS 3456
#define XB_SPIN_CAP (1u << 18)

__device__ __forceinline__ unsigned xb_ld(unsigned* p)              { return __hip_atomic_load(p, __ATOMIC_RELAXED, __HIP_MEMORY_SCOPE_AGENT); }
__device__ __forceinline__ unsigned xb_add(unsigned* p, unsigned v) { return __hip_atomic_fetch_add(p, v, __ATOMIC_RELAXED, __HIP_MEMORY_SCOPE_AGENT); }
__device__ __forceinline__ unsigned xb_xcc_id() { return (unsigned)__builtin_amdgcn_s_getreg((3 << 11) | 20) & 0xFu; }
#define XB_SPIN(cond, bar) do { unsigned _sp = 0; while (cond) { __builtin_amdgcn_s_sleep(1); \
    if ((++_sp & 255u) == 0u) { if (xb_ld(&(bar)[XB_TMO])) break; if (_sp > XB_SPIN_CAP) { atomicAdd(&(bar)[XB_TMO], 1u); break; } } } } while (0)

struct XcdBarrier {
    unsigned* bar; unsigned x;
    volatile LAS unsigned* st;
};

__device__ __forceinline__ XcdBarrier xcd_barrier_post(unsigned* bar, volatile LAS unsigned* st) {
    XcdBarrier b; b.bar = bar; b.x = xb_xcc_id(); b.st = st;
    if (threadIdx.x == 0) (void)xb_add(&bar[XB_XCNT(b.x)], 1u);
    return b;
}
__device__ __forceinline__ void xcd_barrier_complete(unsigned* bar, unsigned x, unsigned& nloc, unsigned& nx) {
    const unsigned G = gridDim.x * gridDim.y * gridDim.z;
    unsigned sum, cnt, mine, sp = 0u;
    for (;;) {
        sum = 0u; cnt = 0u; mine = 0u;
#pragma unroll
        for (unsigned j = 0; j < 16; ++j) { const unsigned c = xb_ld(&bar[XB_XCNT(j)]); sum += c; cnt += (c > 0u) ? 1u : 0u; mine = (j == x) ? c : mine; }
        if (sum == G) break;
        __builtin_amdgcn_s_sleep(1);
        if ((++sp & 255u) == 0u) { if (xb_ld(&bar[XB_TMO])) break; if (sp > XB_SPIN_CAP) { atomicAdd(&bar[XB_TMO], 1u); break; } }
    }
    nloc = mine > 0u ? mine : 1u; nx = cnt > 0u ? cnt : 1u;
}

__device__ __forceinline__ void xcd_barrier(const XcdBarrier& b) {
    asm volatile("s_waitcnt vmcnt(0)" ::: "memory");
    __syncthreads();
    if (threadIdx.x == 0) {
        unsigned* bar = b.bar;
        __builtin_amdgcn_s_waitcnt(0);
        unsigned nloc = b.st[0], nx = b.st[1];
        if (nloc == 0u) { xcd_barrier_complete(bar, b.x, nloc, nx); b.st[0] = nloc; b.st[1] = nx; }
        const unsigned old = xb_add(&bar[XB_XSUB(b.x)], 1u);
        const unsigned gen = old / nloc;
        if (old + 1u == (gen + 1u) * nloc) {
            __builtin_amdgcn_fence(__ATOMIC_RELEASE, "agent");
            asm volatile("s_waitcnt vmcnt(0)" ::: "memory");
            const unsigned og = xb_add(&bar[XB_TOP], 1u);
            const unsigned tg = og / nx;
            if (og + 1u == (tg + 1u) * nx) xb_add(&bar[XB_TOPGEN], 1u);
            else XB_SPIN(xb_ld(&bar[XB_TOPGEN]) == tg, bar);
            __builtin_amdgcn_fence(__ATOMIC_ACQUIRE, "agent");
            xb_add(&bar[XB_XGEN(b.x)], 1u);
            asm volatile("s_waitcnt vmcnt(0)" ::: "memory");
        } else {
            XB_SPIN(xb_ld(&bar[XB_XGEN(b.x)]) == gen, bar);
            __builtin_amdgcn_fence(__ATOMIC_ACQUIRE, "agent");
            asm volatile("s_waitcnt vmcnt(0)" ::: "memory");
        }
    }
    __syncthreads();
}

__device__ __forceinline__ void grid_barrier(unsigned* ctr, unsigned& epoch, const unsigned G) {
    asm volatile("s_waitcnt vmcnt(0) lgkmcnt(0)" ::: "memory");
    __syncthreads();
    epoch += G;
    if (threadIdx.x == 0) {
        __builtin_amdgcn_fence(__ATOMIC_RELEASE, "agent");
        asm volatile("s_waitcnt vmcnt(0)" ::: "memory");
        __hip_atomic_fetch_add(ctr, 1u, __ATOMIC_RELAXED, __HIP_MEMORY_SCOPE_AGENT);
        while (__hip_atomic_load(ctr, __ATOMIC_RELAXED, __HIP_MEMORY_SCOPE_AGENT) < epoch) __builtin_amdgcn_s_sleep(1);
        __builtin_amdgcn_fence(__ATOMIC_ACQUIRE, "agent");
        asm volatile("s_waitcnt vmcnt(0)" ::: "memory");
    }
    __syncthreads();
}

constexpr int NPH = 27;
__global__ void __launch_bounds__(512) fwd_megakernel(Params p) {
    extern __shared__ __attribute__((aligned(16))) unsigned char smem[];
    char* lds = (char*)smem;
    LAS unsigned char* ldsl = (LAS unsigned char*)smem;
    cg::grid_group grid = cg::this_grid();
    unsigned char* ws = p.ws;
    const int tid = threadIdx.x, G = gridDim.x, bid = blockIdx.x;
#define PHASE(n) if (p.ph_lo <= (n) && (n) < p.ph_hi)
#define SYNC(n) do { if (p.ph_lo <= (n) && (n) + 1 < p.ph_hi) { xcd_barrier(xbar); } } while (0)
    volatile LAS unsigned* xst = (volatile LAS unsigned*)(ldsl + LDS_ITEM_OFF + 16);
    if (tid == 0) { xst[0] = 0u; xst[1] = 0u; }
    __syncthreads();
    XcdBarrier xbar = xcd_barrier_post((unsigned*)(ws + WS_BAR), xst);
    if (p.ph_lo < 0) grid.sync();
    float* X = (float*)(ws + WS_X); bf16_t* H = (bf16_t*)(ws + WS_H); bf16_t* Gb = (bf16_t*)(ws + WS_GP); float* Pb = (float*)(ws + WS_GP);
    bf16_t* MIX = (bf16_t*)(ws + WS_MIX);
    const float* MOD = (const float*)(ws + WS_MOD);
    float* PART = (float*)(ws + WS_PART); const bool split_ok = (G == 256);

    PHASE(0) {
        if (bid == 0 && tid < 64) ((unsigned*)(ws + WS_CTRL))[tid] = 0u;
        if (bid == G - 1) rope_tables(p);
        { const size_t nc4 = (size_t)NCTX * DM / 4;
          for (size_t i = (size_t)bid * 512 + tid; i < nc4; i += (size_t)G * 512) ((f32x4*)(X + (size_t)NLAT * DM))[i] = ((const f32x4*)p.in[2])[i]; }
        { bool first = true; for (int it = bid; it < N_GEMV; it += G) { gemv_item(p, it, lds, first); first = false; } }
        if (G == 256) {
            const int nvw = 32 + 224 * 3, w0 = bid < 32 ? bid : 32 + (bid - 32) * 3, nw = bid < 32 ? 1 : 3;
#pragma unroll 1
            for (int w = w0; w < w0 + nw; ++w) { transpose_set(p, 0, 1, w, nvw, lds); transpose_set(p, 0, 0, w, nvw, lds); transpose_set(p, 1, 0, w, nvw, lds); }
        } else { transpose_set(p, 0, 1, bid, G, lds); transpose_set(p, 0, 0, bid, G, lds); transpose_set(p, 1, 0, bid, G, lds); }
        if (G <= 12) { transpose_set(p, 0, 2, bid, G, lds); transpose_set(p, 1, 1, bid, G, lds); transpose_set(p, 1, 2, bid, G, lds); }
    }
    SYNC(0);
#pragma unroll 1
    for (int l = 0; l < 2; ++l) {
        const int pb = 2 + 12 * l;
        const float* modl = MOD + (size_t)l * 5 * MODW;
        const bool last = (l == 1);
        PHASE(pb + 0) norm_phase(X, H, modl, 0, 1, NTOK, (l > 0 && split_ok) ? PART : nullptr, l == 0 ? p.in[0] : nullptr);
        SYNC(pb + 0);
        PHASE(pb + 1) { pg8::Gemm g{H, (const bf16_t*)(ws + WS_W1IN + l * SZ_WFIN), NTOK, 2 * FH, DM}; pg8::StaticOrder S; S.init(g.M, g.N, g.K, G, bid, 0); EpiSwiglu E{Gb}; pg8::gemm_phase(ldsl, g, S, E);
            if (G > 12 && bid >= 12) transpose_set(p, l, 2, bid - 12, G - 12, lds, 0, G == 256 ? 3 : 4); }
        SYNC(pb + 1);
        PHASE(pb + 2) { pg8::Gemm g{Gb, (const bf16_t*)(ws + WS_W1OUT + l * SZ_WFOUT), NTOK, DM, FH}; pg8::StaticOrder S; S.init(g.M, g.N, g.K, G, bid, 1); EpiResid E{X, PART, l == 0 ? p.in[0] : X, modl + 2 * DM, 0.5f}; pg8::gemm_phase(ldsl, g, S, E); }
        SYNC(pb + 2);
        PHASE(pb + 3) norm_phase(X, H, modl, 3, 4, NTOK, split_ok ? PART : nullptr, nullptr);
        SYNC(pb + 3);
        PHASE(pb + 4) { pg8::Gemm g{H, (const bf16_t*)(ws + WS_WIN + l * SZ_WIN), NTOK, INWP, DM}; pg8::StaticOrder S; S.init(g.M, g.N, g.K, G, bid, 0); EpiBf16 E{(bf16_t*)Pb, INWP, -1, nullptr, nullptr}; pg8::gemm_phase(ldsl, g, S, E);
            if (G == 256 && bid >= 208) transpose_set(p, l, 2, bid - 208, 48, lds, 3, 4); }
        SYNC(pb + 4);
        PHASE(pb + 5) {
            prep_phase(p, l);
            for (int job = bid; job < NCHAIN * NCHUNK; job += G) hgrn_chunk_job(p, l, job, lds);
        }
        SYNC(pb + 5);
        PHASE(pb + 6) {
            const float* tab = (const float*)(ws + WS_ROPE);
            { pg8::Gemm g{(const bf16_t*)(ws + WS_CQN), (const bf16_t*)(ws + WS_WUQ + l * SZ_WUQ), NTOK, 768, 512}; pg8::StaticOrder S; S.init(g.M, g.N, g.K, G, bid, 0);
              EpiBf16 E{(bf16_t*)(ws + WS_UQ), 768, 2, tab + 4096, tab + 5120}; pg8::gemm_phase(ldsl, g, S, E); }
            { pg8::Gemm g{(const bf16_t*)(ws + WS_CKVN), (const bf16_t*)(ws + WS_WUKV + l * SZ_WUKV), NTOK, 1024, 256}; pg8::StaticOrder S; S.init(g.M, g.N, g.K, G, (bid + G - 108) % G, 0);
              EpiBf16 E{(bf16_t*)(ws + WS_UKV), 1024, -1, tab + 4096, tab + 5120}; pg8::gemm_phase(ldsl, g, S, E); }
            hgrn_scan_phase(p);
        }
        SYNC(pb + 6);
        PHASE(pb + 7) mixer_queue_phase(p, l, lds);
        SYNC(pb + 7);
        const int Mrows = last ? NLAT : NTOK;
        PHASE(pb + 8) { pg8::Gemm g{MIX, (const bf16_t*)(ws + WS_WOUT + l * SZ_WOUT), Mrows, DM, DM}; pg8::StaticOrder S; S.init(g.M, g.N, g.K, G, bid, 1); EpiResid E{X, PART, X, modl + 5 * DM, 1.0f}; pg8::gemm_phase(ldsl, g, S, E); }
        SYNC(pb + 8);
        PHASE(pb + 9) norm_phase(X, H, modl, 6, 7, Mrows, (!last && split_ok) ? PART : nullptr, nullptr);
        SYNC(pb + 9);
        PHASE(pb + 10) { pg8::Gemm g{H, (const bf16_t*)(ws + WS_W2IN + l * SZ_WFIN), Mrows, 2 * FH, DM}; pg8::StaticOrder S; S.init(g.M, g.N, g.K, G, bid, 0); EpiSwiglu E{Gb}; pg8::gemm_phase(ldsl, g, S, E);
            if (!last && G > 12 && bid >= 12) transpose_set(p, 1, 1, bid - 12, G - 12, lds); }
        SYNC(pb + 10);
        PHASE(pb + 11) { pg8::Gemm g{Gb, (const bf16_t*)(ws + WS_W2OUT + l * SZ_WFOUT), Mrows, DM, FH}; pg8::StaticOrder S; S.init(g.M, g.N, g.K, G, bid, 1); EpiResid E{X, PART, X, modl + 8 * DM, 0.5f}; pg8::gemm_phase(ldsl, g, S, E); }
        SYNC(pb + 11);
    }
    PHASE(26) final_phase(X, p.out, p.in[20]);
#undef PHASE
#undef SYNC
}

extern "C" void kernel_launch(void* const* d_in, const int* in_sizes, int n_in, void* d_out, int out_size, void* d_ws, size_t ws_size, hipStream_t stream) {
    static int grid_blocks = 0;
    if (grid_blocks == 0) {
        if (n_in != 21 || ws_size < WS_END) { fprintf(stderr, "kernel_launch: n_in %d ws %zu (need %zu)\n", n_in, ws_size, (size_t)WS_END); grid_blocks = -1; return; }
        int dev = 0, cus = 0, per_cu = 0;
        (void)hipGetDevice(&dev);
        (void)hipDeviceGetAttribute(&cus, hipDeviceAttributeMultiprocessorCount, dev);
        if (hipFuncSetAttribute((const void*)fwd_megakernel, hipFuncAttributeMaxDynamicSharedMemorySize, LDS_BYTES) != hipSuccess) { fprintf(stderr, "kernel_launch: hipFuncSetAttribute failed\n"); grid_blocks = -1; return; }
        (void)hipOccupancyMaxActiveBlocksPerMultiprocessor(&per_cu, (const void*)fwd_megakernel, 512, LDS_BYTES);
        if (per_cu < 1) { fprintf(stderr, "kernel_launch: occupancy query says %d\n", per_cu); per_cu = 1; }
        grid_blocks = cus * 1;
        (void)hipGetLastError();
    }
    if (grid_blocks < 0) return;
    (void)hipMemsetAsync((char*)d_ws + WS_BAR, 0, 16384, stream);
    Params p{};
    for (int i = 0; i < 21; ++i) p.in[i] = (const float*)d_in[i];
    p.out = (float*)d_out; p.ws = (unsigned char*)d_ws;
#if ONE_LAUNCH
    p.ph_lo = 0; p.ph_hi = NPH;
    void* args[] = {&p};
    hipError_t e = hipLaunchCooperativeKernel((const void*)fwd_megakernel, dim3(grid_blocks), dim3(512), args, LDS_BYTES, stream);
    if (e != hipSuccess) fprintf(stderr, "cooperative launch failed: %s (grid %d)\n", hipGetErrorString(e), grid_blocks);
#else
    for (int ph = 0; ph < NPH; ++ph) { p.ph_lo = ph; p.ph_hi = ph + 1; hipLaunchKernelGGL(fwd_megakernel, dim3(grid_blocks), dim3(512), LDS_BYTES, stream, p); }
#endif
}
```

```cpp
#include <hip/hip_runtime.h>
#include <hip/hip_cooperative_groups.h>
#include <cstdio>
#include <cstdint>
namespace cg = cooperative_groups;

#ifndef ONE_LAUNCH
#define ONE_LAUNCH 1
#endif

typedef unsigned short bf16_t;
typedef short bf16x8 __attribute__((ext_vector_type(8)));
typedef short s16x4 __attribute__((ext_vector_type(4)));
typedef float f32x4 __attribute__((ext_vector_type(4)));
typedef float f32x2 __attribute__((ext_vector_type(2)));
typedef float f32x16 __attribute__((ext_vector_type(16)));
typedef unsigned u32x4 __attribute__((ext_vector_type(4)));
typedef unsigned u32x2 __attribute__((ext_vector_type(2)));
#define LAS __attribute__((address_space(3)))

constexpr int DM = 2048, NB = 4, SEQ = 2048, CTXL = 256, NLAT = NB * SEQ, NCTX = NB * CTXL, NTOK = NLAT + NCTX;
constexpr int FH = 5504, INW = 4928, INWP = 5120, MODW = 9 * DM;
constexpr int SKV = SEQ + CTXL;
constexpr float EPS = 1e-6f;
constexpr float LOG2E = 1.4426950408889634f;
constexpr int PC_GQ = 0, PC_GK = 1024, PC_GV = 1280, PC_HQ = 1536, PC_HI = 2048, PC_HF = 2560, PC_HB = 3072, PC_HG = 3584, PC_CQ = 4096, PC_CKV = 4608, PC_KR = 4864;
constexpr int NCHUNK = 36, NCHAIN = 32;

constexpr size_t al256(size_t x) { return (x + 255) / 256 * 256; }
constexpr size_t WS_CTRL = 0;
constexpr size_t WS_ROPE = 4096;
constexpr size_t WS_MOD = WS_ROPE + 32768;
constexpr size_t WS_MPART = WS_MOD + al256((size_t)2 * 5 * MODW * 4);
constexpr size_t WS_W1IN = WS_MPART + al256((size_t)8 * 2 * 5 * MODW * 4);
constexpr size_t SZ_WFIN = (size_t)2 * FH * DM * 2;
constexpr size_t WS_W2IN = WS_W1IN + 2 * SZ_WFIN;
constexpr size_t WS_W1OUT = WS_W2IN + 2 * SZ_WFIN;
constexpr size_t SZ_WFOUT = (size_t)DM * FH * 2;
constexpr size_t WS_W2OUT = WS_W1OUT + 2 * SZ_WFOUT;
constexpr size_t WS_WIN = WS_W2OUT + 2 * SZ_WFOUT;
constexpr size_t SZ_WIN = (size_t)INWP * DM * 2;
constexpr size_t WS_WOUT = WS_WIN + 2 * SZ_WIN;
constexpr size_t SZ_WOUT = (size_t)DM * DM * 2;
constexpr size_t WS_WUQ = WS_WOUT + 2 * SZ_WOUT;
constexpr size_t SZ_WUQ = (size_t)768 * 512 * 2;
constexpr size_t WS_WUKV = WS_WUQ + 2 * SZ_WUQ;
constexpr size_t SZ_WUKV = (size_t)1024 * 256 * 2;
constexpr size_t WS_X = WS_WUKV + 2 * SZ_WUKV;
constexpr size_t WS_H = WS_X + (size_t)NTOK * DM * 4;
constexpr size_t WS_GP = WS_H + (size_t)NTOK * DM * 2;
constexpr size_t WS_QA = WS_GP + (size_t)NTOK * INWP * 4;
constexpr size_t WS_KA = WS_QA + (size_t)NTOK * 1024 * 2;
constexpr size_t WS_VA = WS_KA + (size_t)NTOK * 256 * 2;
constexpr size_t WS_CQN = WS_VA + (size_t)NTOK * 256 * 2;
constexpr size_t WS_CKVN = WS_CQN + (size_t)NTOK * 512 * 2;
constexpr size_t WS_UQ = WS_CKVN + (size_t)NTOK * 256 * 2;
constexpr size_t WS_UKV = WS_UQ + (size_t)NTOK * 768 * 2;
constexpr size_t WS_KR = WS_UKV + (size_t)NTOK * 1024 * 2;
constexpr size_t WS_MIX = WS_KR + (size_t)NTOK * 64 * 2;
constexpr size_t WS_ST = WS_MIX + (size_t)NTOK * DM * 2;
constexpr size_t WS_DEC = WS_ST + (size_t)NCHAIN * NCHUNK * 16384 * 4;
constexpr size_t WS_QE = WS_DEC + (size_t)NCHAIN * NCHUNK * 128 * 4;
constexpr size_t WS_OI = WS_QE + (size_t)NCHAIN * NCHUNK * 8192 * 2;
constexpr size_t WS_PART = WS_OI + (size_t)2 * NTOK * 512 * 4;
constexpr size_t WS_ST2 = WS_PART + (size_t)8 * NCTX * DM * 4;
constexpr size_t WS_BAR = WS_ST2 + (size_t)NCHAIN * NCHUNK * 16384 * 4;
constexpr size_t WS_END = WS_BAR + 16384;

constexpr int LDS_BYTES = 160 * 1024;
constexpr int LDS_ITEM_OFF = 159 * 1024;

struct Params { const float* in[21]; float* out; unsigned char* ws; int ph_lo, ph_hi; };

__device__ __forceinline__ unsigned cvt_pk_bf16(float lo, float hi) { unsigned r; asm("v_cvt_pk_bf16_f32 %0, %1, %2" : "=v"(r) : "v"(lo), "v"(hi)); return r; }
__device__ __forceinline__ bf16_t f2bf(float x) { return (bf16_t)(cvt_pk_bf16(x, 0.f) & 0xffffu); }
__device__ __forceinline__ float bf2f(bf16_t b) { return __uint_as_float(((unsigned)b) << 16); }
__device__ __forceinline__ f32x4 bf4_to_f4(u32x2 w) { return (f32x4){__uint_as_float(w.x << 16), __uint_as_float(w.x & 0xffff0000u), __uint_as_float(w.y << 16), __uint_as_float(w.y & 0xffff0000u)}; }
__device__ __forceinline__ float wave_sum(float v) {
#pragma unroll
    for (int o = 32; o >= 1; o >>= 1) v += __shfl_xor(v, o, 64);
    return v;
}
__device__ __forceinline__ float half_sum(float v) {
#pragma unroll
    for (int o = 16; o >= 1; o >>= 1) v += __shfl_xor(v, o, 64);
    return v;
}
__device__ __forceinline__ float sigmoidf_(float x) { return 1.f / (1.f + __expf(-x)); }
__device__ __forceinline__ int otid() { int t = threadIdx.x; asm volatile("" : "+v"(t)); return t; }
__device__ __forceinline__ int crow(int r, int hi) { return (r & 3) + 8 * (r >> 2) + 4 * hi; }

namespace pg8 {
constexpr int BM = 256, BK = 64, HALF = 128, HTB = HALF * BK * 2, STAGE_BYTES = 8 * HTB, NXCD = 8, WGM = 8;
__host__ __device__ __forceinline__ int lds_byte(int r, int c) { const int st = (r >> 4) * 2 + (c >> 5), rr = r & 15, cc = c & 31, ob = rr * 64 + cc * 2; return st * 1024 + (ob ^ (((ob >> 9) & 1) << 5)); }
__host__ __device__ __forceinline__ void stage_rc(int b, int& R, int& C) { const int st = b / 1024, sb = b % 1024, swz = sb ^ (((sb >> 9) & 1) << 5); R = (st >> 1) * 16 + swz / 64; C = (st & 1) * 32 + (swz % 64) / 2; }
struct Unit { int pm, pn, k0, nk, part, ks; };
struct Gemm { const bf16_t* A; const bf16_t* Bt; int M, N, K; };
struct StaticOrder {
    int nM, nN, nwg, G, c, nkt, split;
    __device__ __forceinline__ void init(int M, int N, int K, int G_, int c_, int split_) { nM = M / BM; nN = N / BM; G = G_; c = c_; nkt = K / BK; split = (split_ && nM == 36 && nN == 8 && G_ == 256) ? 1 : 0; if (split) nM = 32; nwg = nM * nN; }
    __device__ __forceinline__ void decode(int wg, Unit& u) const {
        int wgid = wg; { const int q = nwg / NXCD, r = nwg % NXCD, xcd = wgid % NXCD, off = wgid / NXCD; wgid = (xcd < r ? xcd * (q + 1) : r * (q + 1) + (xcd - r) * q) + off; }
        const int nig = WGM * nN, gid = wgid / nig, fm = gid * WGM, gsz = (nM - fm) < WGM ? (nM - fm) : WGM;
        u.pm = fm + ((wgid % nig) % gsz); u.pn = (wgid % nig) / gsz;
    }
    __device__ __forceinline__ bool next(int i, Unit& u) const {
        const long L = (long)i * G + c;
        if (L < nwg) { decode((int)L, u); u.k0 = 0; u.nk = nkt; u.part = 0; u.ks = 0; return true; }
        if (!split || i != 1) return false;
        const int j = c, t = j >> 3, s = j & 7;
        u.pm = 32 + (t >> 3); u.pn = t & 7;
        const int npair = nkt >> 1, base = npair >> 3, rem = npair & 7;
        const int p0 = s * base + (s < rem ? s : rem), np = base + (s < rem ? 1 : 0);
        u.k0 = 2 * p0; u.nk = 2 * np; u.part = 1; u.ks = s; return true;
    }
};

template <class Epi>
__device__ __forceinline__ void gemm_phase(LAS unsigned char* lds, const Gemm g, const StaticOrder S, const Epi E) {
    const int tid = otid(), wid = __builtin_amdgcn_readfirstlane(tid >> 6), lane = tid & 63, wr = wid >> 2, wc = wid & 3, fr = lane & 15, fq = lane >> 4;
    const int K = g.K;
    unsigned voffA[2];
#pragma unroll
    for (int i = 0; i < 2; ++i) { int R, C; stage_rc(tid * 16 + i * 8192, R, C); voffA[i] = (unsigned)(R * K + C) * 2u; }
    const size_t kstep = (size_t)(BK * 2);
    const size_t hstep = (size_t)HALF * K * 2;
    const size_t tstep = 2 * hstep;
    const unsigned ldsw = (unsigned)wid * 1024u;
    const int aoff = lds_byte(wr * 64 + fr, fq * 8), boff = lds_byte(wc * 32 + fr, fq * 8);
#define PG8_SA(b, h) (((b) * 2 + (h)) * HTB)
#define PG8_SB(b, h) ((4 + (b) * 2 + (h)) * HTB)
#define PG8_STAGE(bufoff, gbase, voff) do { _Pragma("unroll") for (int _i = 0; _i < 2; ++_i) \
        __builtin_amdgcn_global_load_lds((const unsigned*)((const char*)(gbase) + (voff)[_i]), (LAS unsigned*)(lds + (bufoff) + ldsw + _i * 8192), 16, 0, 0); } while (0)
#define PG8_LDA(dst, b, h) do { _Pragma("unroll") for (int m = 0; m < 4; ++m) _Pragma("unroll") for (int k = 0; k < 2; ++k) dst[m][k] = *(const LAS bf16x8*)(lds + PG8_SA(b, h) + aoff + m * 2048 + k * 1024); } while (0)
#define PG8_LDB(dst, b, h) do { _Pragma("unroll") for (int n = 0; n < 2; ++n) _Pragma("unroll") for (int k = 0; k < 2; ++k) dst[n][k] = *(const LAS bf16x8*)(lds + PG8_SB(b, h) + boff + n * 2048 + k * 1024); } while (0)
#define PG8_MMA(ai, bj, At, Bt) do { __builtin_amdgcn_s_setprio(1); _Pragma("unroll") for (int m = 0; m < 4; ++m) _Pragma("unroll") for (int n = 0; n < 2; ++n) _Pragma("unroll") for (int k = 0; k < 2; ++k) \
        acc[ai][bj][m][n] = __builtin_amdgcn_mfma_f32_16x16x32_bf16(Bt[n][k], At[m][k], acc[ai][bj][m][n], 0, 0, 0); __builtin_amdgcn_s_setprio(0); } while (0)
#define PG8_WAIT_V(n) asm volatile("s_waitcnt vmcnt(" #n ")" ::: "memory")
#define PG8_WAIT_L(n) asm volatile("s_waitcnt lgkmcnt(" #n ")" ::: "memory")
#define PG8_BAR __builtin_amdgcn_s_barrier()
#define PG8_SCHED __builtin_amdgcn_sched_barrier(0)
    Unit cur, nxt; int ui = 0;
    if (!S.next(0, cur)) return;
    f32x4 acc[2][2][4][2];
#pragma unroll
    for (int a = 0; a < 2; ++a)
#pragma unroll
        for (int b = 0; b < 2; ++b)
#pragma unroll
            for (int m = 0; m < 4; ++m)
#pragma unroll
                for (int n = 0; n < 2; ++n) acc[a][b][m][n] = (f32x4){0.f, 0.f, 0.f, 0.f};
    bf16x8 At[4][2], B0[2][2], B1[2][2];
    const char* cA = (const char*)g.A + (size_t)cur.pm * tstep + (size_t)cur.k0 * kstep; const char* cB = (const char*)g.Bt + (size_t)cur.pn * tstep + (size_t)cur.k0 * kstep;
    PG8_STAGE(PG8_SB(0, 0), cB, voffA); PG8_STAGE(PG8_SA(0, 0), cA, voffA); PG8_STAGE(PG8_SB(0, 1), cB + hstep, voffA); PG8_STAGE(PG8_SA(0, 1), cA + hstep, voffA);
    if (wr == 1) PG8_BAR;
    PG8_WAIT_V(4); PG8_BAR;
    PG8_STAGE(PG8_SB(1, 0), cB + kstep, voffA); PG8_STAGE(PG8_SA(1, 0), cA + kstep, voffA); PG8_STAGE(PG8_SB(1, 1), cB + hstep + kstep, voffA);
    PG8_WAIT_V(6); PG8_BAR;
    for (;;) {
        const bool has_next = S.next(ui + 1, nxt);
        const char* nA = has_next ? (const char*)g.A + (size_t)nxt.pm * tstep + (size_t)nxt.k0 * kstep : cA; const char* nB = has_next ? (const char*)g.Bt + (size_t)nxt.pn * tstep + (size_t)nxt.k0 * kstep : cB;
        const int nt = cur.nk;
        for (int t = 0; t < nt; t += 2) {
            const bool last = (t == nt - 2);
            const char* a1 = cA + (size_t)(t + 1) * kstep;
            const char* a2 = last ? nA : cA + (size_t)(t + 2) * kstep; const char* b2 = last ? nB : cB + (size_t)(t + 2) * kstep;
            const char* a3 = a2 + kstep; const char* b3 = b2 + kstep;
            PG8_LDB(B0, 0, 0); PG8_SCHED; PG8_LDA(At, 0, 0); PG8_STAGE(PG8_SA(1, 1), a1 + hstep, voffA);
            PG8_WAIT_L(8); PG8_BAR; PG8_WAIT_L(0); PG8_MMA(0, 0, At, B0); PG8_BAR; PG8_SCHED;
            PG8_LDB(B1, 0, 1); PG8_STAGE(PG8_SB(0, 0), b2, voffA);
            PG8_BAR; PG8_WAIT_L(0); PG8_MMA(0, 1, At, B1); PG8_BAR;
            PG8_LDA(At, 0, 1); PG8_STAGE(PG8_SA(0, 0), a2, voffA);
            PG8_BAR; PG8_WAIT_L(0); PG8_MMA(1, 0, At, B0); PG8_BAR; PG8_SCHED;
            PG8_STAGE(PG8_SB(0, 1), b2 + hstep, voffA);
            PG8_WAIT_V(6); PG8_BAR; PG8_MMA(1, 1, At, B1); PG8_BAR;
            PG8_LDB(B0, 1, 0); PG8_SCHED; PG8_LDA(At, 1, 0); PG8_STAGE(PG8_SA(0, 1), a2 + hstep, voffA);
            PG8_WAIT_L(8); PG8_BAR; PG8_WAIT_L(0); PG8_MMA(0, 0, At, B0); PG8_BAR; PG8_SCHED;
            PG8_LDB(B1, 1, 1); PG8_STAGE(PG8_SB(1, 0), b3, voffA);
            PG8_BAR; PG8_WAIT_L(0); PG8_MMA(0, 1, At, B1); PG8_BAR;
            PG8_LDA(At, 1, 1); PG8_STAGE(PG8_SA(1, 0), a3, voffA);
            PG8_BAR; PG8_WAIT_L(0); PG8_MMA(1, 0, At, B0); PG8_BAR; PG8_SCHED;
            PG8_STAGE(PG8_SB(1, 1), b3 + hstep, voffA);
            PG8_WAIT_V(6); PG8_BAR; PG8_MMA(1, 1, At, B1); PG8_BAR;
        }
        E(acc, cur, wr, wc, fr, fq);
        if (!has_next) break;
#pragma unroll
        for (int a = 0; a < 2; ++a)
#pragma unroll
            for (int b = 0; b < 2; ++b)
#pragma unroll
                for (int m = 0; m < 4; ++m)
#pragma unroll
                    for (int n = 0; n < 2; ++n) acc[a][b][m][n] = (f32x4){0.f, 0.f, 0.f, 0.f};
        cur = nxt; cA = nA; cB = nB; ++ui;
    }
    PG8_WAIT_V(0);
    if (wr == 0) PG8_BAR;
    PG8_BAR;
#undef PG8_SA
#undef PG8_SB
#undef PG8_STAGE
#undef PG8_LDA
#undef PG8_LDB
#undef PG8_MMA
#undef PG8_WAIT_V
#undef PG8_WAIT_L
#undef PG8_BAR
#undef PG8_SCHED
}
}

typedef const f32x4 (&AccRef)[2][2][4][2];

struct EpiSwiglu {
    bf16_t* G;
    __device__ __forceinline__ void operator()(AccRef acc, const pg8::Unit& u, int wr, int wc, int fr, int fq) const {
        const int row0 = u.pm * 256 + wr * 64 + fr, col0 = u.pn * 128 + wc * 16 + 4 * fq;
#pragma unroll
        for (int ai = 0; ai < 2; ++ai)
#pragma unroll
            for (int m = 0; m < 4; ++m) { bf16_t* rowp = G + (size_t)(row0 + ai * 128 + m * 16) * FH + col0;
#pragma unroll
                for (int bj = 0; bj < 2; ++bj) { const f32x4 gq = acc[ai][bj][m][0], uq = acc[ai][bj][m][1]; float v[4];
#pragma unroll
                    for (int i = 0; i < 4; ++i) v[i] = gq[i] * uq[i] * __builtin_amdgcn_rcpf(1.f + __builtin_amdgcn_exp2f(-gq[i] * LOG2E));
                    u32x2 w; w.x = cvt_pk_bf16(v[0], v[1]); w.y = cvt_pk_bf16(v[2], v[3]);
                    *(u32x2*)(rowp + bj * 64) = w; } }
    }
};
struct EpiResid {
    float* X; float* PART; const float* SRC; const float* gate; float coef;
    __device__ __forceinline__ void operator()(AccRef acc, const pg8::Unit& u, int wr, int wc, int fr, int fq) const {
        const int row0 = u.pm * 256 + wr * 64 + fr, col0 = u.pn * 256 + wc * 32 + 4 * fq;
        const int v = u.pm < 32 ? (u.pm >> 3) : 4;
        f32x4 gv[2][2];
#pragma unroll
        for (int bj = 0; bj < 2; ++bj)
#pragma unroll
            for (int n = 0; n < 2; ++n) gv[bj][n] = *(const f32x4*)(gate + (size_t)v * MODW + col0 + bj * 128 + n * 16) * coef;
        const bool part = u.part != 0;
        float* base = part ? PART + ((size_t)u.ks * NCTX - NLAT) * DM : X;
#pragma unroll
        for (int ai = 0; ai < 2; ++ai)
#pragma unroll
            for (int mp = 0; mp < 2; ++mp) {
                f32x4 old[2][2][2];
                if (!part) {
#pragma unroll
                    for (int mm = 0; mm < 2; ++mm)
#pragma unroll
                        for (int bj = 0; bj < 2; ++bj)
#pragma unroll
                            for (int n = 0; n < 2; ++n) old[mm][bj][n] = *(const f32x4*)(SRC + (size_t)(row0 + ai * 128 + (2 * mp + mm) * 16) * DM + col0 + bj * 128 + n * 16);
                }
#pragma unroll
                for (int mm = 0; mm < 2; ++mm)
#pragma unroll
                    for (int bj = 0; bj < 2; ++bj)
#pragma unroll
                        for (int n = 0; n < 2; ++n) { const int m = 2 * mp + mm; const f32x4 d = gv[bj][n] * acc[ai][bj][m][n];
                            *(f32x4*)(base + (size_t)(row0 + ai * 128 + m * 16) * DM + col0 + bj * 128 + n * 16) = part ? d : old[mm][bj][n] + d; }
            }
    }
};
struct EpiF32 {
    float* C; int ldc;
    __device__ __forceinline__ void operator()(AccRef acc, const pg8::Unit& u, int wr, int wc, int fr, int fq) const {
        const int row0 = u.pm * 256 + wr * 64 + fr, col0 = u.pn * 256 + wc * 32 + 4 * fq;
#pragma unroll
        for (int ai = 0; ai < 2; ++ai)
#pragma unroll
            for (int m = 0; m < 4; ++m) { float* rowp = C + (size_t)(row0 + ai * 128 + m * 16) * ldc + col0;
#pragma unroll
                for (int bj = 0; bj < 2; ++bj)
#pragma unroll
                    for (int n = 0; n < 2; ++n) *(f32x4*)(rowp + bj * 128 + n * 16) = acc[ai][bj][m][n]; }
    }
};
struct EpiBf16 {
    bf16_t* O; int ldc; int rope_pn; const float* cos64; const float* sin64;
    __device__ __forceinline__ void operator()(AccRef acc, const pg8::Unit& u, int wr, int wc, int fr, int fq) const {
        const int row0 = u.pm * 256 + wr * 64 + fr, col0 = u.pn * 256 + wc * 32 + 4 * fq;
        const bool rope = (u.pn == rope_pn) && (u.pm < 32);
#pragma unroll
        for (int ai = 0; ai < 2; ++ai)
#pragma unroll
            for (int m = 0; m < 4; ++m) { const int row = row0 + ai * 128 + m * 16; bf16_t* rowp = O + (size_t)row * ldc + col0;
                f32x4 cs = {1.f, 1.f, 1.f, 1.f}, sn = {0.f, 0.f, 0.f, 0.f};
                if (rope) { const int t = row & 2047; const int pos = (wc & 1) ? (t & 63) : (t >> 6); cs = *(const f32x4*)(cos64 + pos * 16 + 4 * fq); sn = *(const f32x4*)(sin64 + pos * 16 + 4 * fq); }
#pragma unroll
                for (int bj = 0; bj < 2; ++bj) {
                    const f32x4 x0 = acc[ai][bj][m][0], x1 = acc[ai][bj][m][1];
                    const f32x4 y0 = x0 * cs - x1 * sn, y1 = x1 * cs + x0 * sn;
                    u32x2 w0, w1; w0.x = cvt_pk_bf16(y0[0], y0[1]); w0.y = cvt_pk_bf16(y0[2], y0[3]); w1.x = cvt_pk_bf16(y1[0], y1[1]); w1.y = cvt_pk_bf16(y1[2], y1[3]);
                    *(u32x2*)(rowp + bj * 128) = w0; *(u32x2*)(rowp + bj * 128 + 16) = w1; } }
    }
};

#define SBAR() __builtin_amdgcn_sched_barrier(0)
template <int OFF> __device__ __forceinline__ s16x4 tr_read(int vb) {
    s16x4 r; asm volatile("ds_read_b64_tr_b16 %0, %1 offset:%2" : "=&v"(r) : "v"(vb), "i"(OFF) : "memory"); return r;
}
__device__ __forceinline__ int v_st(int k, int c) { const int kk = (k & ~0xC) | ((k & 4) << 1) | ((k & 8) >> 1); return ((kk >> 3) * 4 + (c >> 5)) * 512 + ((kk & 7) * 32 + (c & 31)) * 2; }
__device__ __forceinline__ int v_rd_base(int lane) { return ((lane & 3) << 3) | (((lane >> 2) & 3) << 6) | (((lane >> 4) & 1) << 5) | (((lane >> 5) & 1) << 8); }
constexpr int v_rd_off(int d0, int ks, int half) { return d0 * 512 + ks * 4096 + half * 2048; }
template <int D0> __device__ __forceinline__ void pv_one(f32x16& od, int vb, bf16x8 pa0, bf16x8 pa1, bf16x8 pa2, bf16x8 pa3) {
    const s16x4 l0 = tr_read<v_rd_off(D0, 0, 0)>(vb), h0 = tr_read<v_rd_off(D0, 0, 1)>(vb), l1 = tr_read<v_rd_off(D0, 1, 0)>(vb), h1 = tr_read<v_rd_off(D0, 1, 1)>(vb);
    const s16x4 l2 = tr_read<v_rd_off(D0, 2, 0)>(vb), h2 = tr_read<v_rd_off(D0, 2, 1)>(vb), l3 = tr_read<v_rd_off(D0, 3, 0)>(vb), h3 = tr_read<v_rd_off(D0, 3, 1)>(vb);
    asm volatile("s_waitcnt lgkmcnt(0)" ::: "memory"); SBAR();
#define PK(L, H) (bf16x8){L[0], L[1], L[2], L[3], H[0], H[1], H[2], H[3]}
    od = __builtin_amdgcn_mfma_f32_32x32x16_bf16(pa0, PK(l0, h0), od, 0, 0, 0);
    od = __builtin_amdgcn_mfma_f32_32x32x16_bf16(pa1, PK(l1, h1), od, 0, 0, 0);
    od = __builtin_amdgcn_mfma_f32_32x32x16_bf16(pa2, PK(l2, h2), od, 0, 0, 0);
    od = __builtin_amdgcn_mfma_f32_32x32x16_bf16(pa3, PK(l3, h3), od, 0, 0, 0);
#undef PK
}
__device__ __forceinline__ void pv_d0(f32x16* o, int vb, bf16x8 pa0, bf16x8 pa1, bf16x8 pa2, bf16x8 pa3) {
    pv_one<0>(o[0], vb, pa0, pa1, pa2, pa3); pv_one<1>(o[1], vb, pa0, pa1, pa2, pa3); pv_one<2>(o[2], vb, pa0, pa1, pa2, pa3); pv_one<3>(o[3], vb, pa0, pa1, pa2, pa3);
}
__device__ __forceinline__ void partialSM(f32x16& p0, f32x16& p1, float& m_reg, float& mn, float& alpha, const float C, const float thr_raw) {
    float pmax = p0[0];
#pragma unroll
    for (int r = 1; r < 16; ++r) pmax = fmaxf(pmax, p0[r]);
#pragma unroll
    for (int r = 0; r < 16; ++r) pmax = fmaxf(pmax, p1[r]);
    { auto rr = __builtin_amdgcn_permlane32_swap(__float_as_uint(pmax), __float_as_uint(pmax), false, false);
      pmax = fmaxf(__uint_as_float(rr[0]), __uint_as_float(rr[1])); }
    if (__builtin_expect(__all(pmax - m_reg <= thr_raw), 1)) { mn = m_reg; alpha = 1.f; }
    else { mn = fmaxf(m_reg, pmax); alpha = __builtin_amdgcn_exp2f((m_reg - mn) * C); m_reg = mn; }
    const float mnC = -mn * C;
#pragma unroll
    for (int r = 0; r < 16; ++r) p0[r] = fmaf(p0[r], C, mnC);
#pragma unroll
    for (int r = 0; r < 16; ++r) p1[r] = fmaf(p1[r], C, mnC);
#pragma unroll
    for (int r = 0; r < 16; ++r) p0[r] = __builtin_amdgcn_exp2f(p0[r]);
}
__device__ __forceinline__ void finishSM(f32x16& p0, f32x16& p1, float alpha, float& l_reg, bf16x8& pa0, bf16x8& pa1, bf16x8& pa2, bf16x8& pa3) {
#pragma unroll
    for (int r = 0; r < 16; ++r) p1[r] = __builtin_amdgcn_exp2f(p1[r]);
    float ps = 0;
#pragma unroll
    for (int r = 0; r < 16; ++r) ps += p0[r];
#pragma unroll
    for (int r = 0; r < 16; ++r) ps += p1[r];
    { auto rr = __builtin_amdgcn_permlane32_swap(__float_as_uint(ps), __float_as_uint(ps), false, false);
      ps = __uint_as_float(rr[0]) + __uint_as_float(rr[1]); }
    l_reg = l_reg * alpha + ps;
#define PK4(P, BASE, OUT) do { unsigned a0 = cvt_pk_bf16(P[BASE + 0], P[BASE + 1]), a1 = cvt_pk_bf16(P[BASE + 2], P[BASE + 3]);   \
    unsigned b0 = cvt_pk_bf16(P[BASE + 4], P[BASE + 5]), b1 = cvt_pk_bf16(P[BASE + 6], P[BASE + 7]);                              \
    auto r0 = __builtin_amdgcn_permlane32_swap(a0, b0, false, false); auto r1 = __builtin_amdgcn_permlane32_swap(a1, b1, false, false); \
    u32x4 w = {r0[0], r1[0], r0[1], r1[1]}; OUT = *reinterpret_cast<bf16x8*>(&w); } while (0)
    PK4(p0, 0, pa0); PK4(p0, 8, pa1); PK4(p1, 0, pa2); PK4(p1, 8, pa3);
#undef PK4
}
template <int DQK> __device__ __forceinline__ int kswz(int row, int colB) { return row * (DQK * 2) + (colB ^ ((row & 7) << 4)); }
template <int DQK> __device__ __forceinline__ void qkt(f32x16& p0, f32x16& p1, const char* Ks, const bf16x8* qr, int r32, int hi) {
    p0 = f32x16{}; p1 = f32x16{};
#pragma unroll
    for (int d0 = 0; d0 < DQK / 16; ++d0) { const int cb = (d0 * 16 + hi * 8) * 2;
        const bf16x8 b0 = *reinterpret_cast<const bf16x8*>(Ks + kswz<DQK>(r32, cb));
        const bf16x8 b1 = *reinterpret_cast<const bf16x8*>(Ks + kswz<DQK>(32 + r32, cb));
        p0 = __builtin_amdgcn_mfma_f32_32x32x16_bf16(b0, qr[d0], p0, 0, 0, 0);
        p1 = __builtin_amdgcn_mfma_f32_32x32x16_bf16(b1, qr[d0], p1, 0, 0, 0); }
}
template <int DQK, int SD>
__device__ __forceinline__ void attn_body(const bf16_t* __restrict__ Qb, const bf16_t* __restrict__ Kh, const bf16_t* __restrict__ Vh,
                                          bf16_t* __restrict__ Ob, const int seq, const float C, const float thr_raw, char* lds) {
    constexpr int ND0 = DQK / 16, KCH = DQK / 64  , KPR = DQK / 8  ;
    constexpr int SHM_V = 64 * 128 * 2, SHM_K = 64 * DQK * 2;
    const int tid = otid(), wid = tid >> 6, lane = tid & 63, r32 = lane & 31, hi = lane >> 5;
    char* V_lds = lds; char* K_lds = lds + 2 * SHM_V;
    float* wsl = (float*)(lds + 2 * SHM_V + 2 * SHM_K) + wid * 64; float* li_l = wsl; float* al_l = wsl + 32;
    float m_reg = -1e30f, l_reg = 0; f32x16 o[4] = {}; bf16x8 qr[ND0];
    const bf16_t* Qw = Qb + (size_t)(wid * 32 + r32) * DQK + hi * 8;
#pragma unroll
    for (int d0 = 0; d0 < ND0; ++d0) qr[d0] = *reinterpret_cast<const bf16x8*>(Qw + d0 * 16);
    const int sr = tid >> 4, sc = (tid & 15) * 8, vst0 = v_st(sr, sc), vst1 = v_st(32 + sr, sc);
    int krow[KCH], kcol[KCH];
#pragma unroll
    for (int i = 0; i < KCH; ++i) { const int cid = tid + 512 * i; krow[i] = cid / KPR; kcol[i] = (cid % KPR) * 8; }
    const int vb0 = (int)(uintptr_t)V_lds + v_rd_base(lane);
    bf16x8 svs0[SD], svs1[SD], sks[SD][KCH]; constexpr int SE = 0, SO = SD - 1;
#define SLOAD(i, k0) do { svs0[i] = *reinterpret_cast<const bf16x8*>(&Vh[(size_t)((k0) + sr) * 128 + sc]); svs1[i] = *reinterpret_cast<const bf16x8*>(&Vh[(size_t)((k0) + 32 + sr) * 128 + sc]); \
    _Pragma("unroll") for (int _c = 0; _c < KCH; ++_c) sks[i][_c] = *reinterpret_cast<const bf16x8*>(&Kh[(size_t)((k0) + krow[_c]) * DQK + kcol[_c]]); } while (0)
#define SWRITE(b, i) do { *(bf16x8*)(V_lds + (b) * SHM_V + vst0) = svs0[i]; *(bf16x8*)(V_lds + (b) * SHM_V + vst1) = svs1[i]; \
    _Pragma("unroll") for (int _c = 0; _c < KCH; ++_c) *(bf16x8*)(K_lds + (b) * SHM_K + kswz<DQK>(krow[_c], kcol[_c] * 2)) = sks[i][_c]; } while (0)
#define SWAIT() do { if constexpr (SD == 1) asm volatile("s_waitcnt vmcnt(0)" ::: "memory"); else if constexpr (KCH == 2) asm volatile("s_waitcnt vmcnt(4)" ::: "memory"); else asm volatile("s_waitcnt vmcnt(5)" ::: "memory"); } while (0)
#define RESC(a) do { if (__any((a) < 1.f)) { if (hi == 0) al_l[r32] = (a); asm volatile("s_waitcnt lgkmcnt(0)" ::: "memory"); \
    _Pragma("unroll") for (int d = 0; d < 4; ++d) _Pragma("unroll") for (int r = 0; r < 16; ++r) o[d][r] *= al_l[crow(r, hi)]; } } while (0)
    f32x16 pA0, pA1, pB0, pB1; float mnA, mnB, alA, alB; bf16x8 pa0, pa1, pa2, pa3; const int NT = seq / 64;
    SLOAD(SE, 0); asm volatile("s_waitcnt vmcnt(0)" ::: "memory"); SWRITE(0, SE); __syncthreads();
    qkt<DQK>(pA0, pA1, K_lds, qr, r32, hi); partialSM(pA0, pA1, m_reg, mnA, alA, C, thr_raw);
    SLOAD(SO, 64); if constexpr (SD == 2) { if (2 < NT) SLOAD(SE, 128); }
    SWAIT(); SWRITE(1, SO); __syncthreads();
    for (int j = 1; j + 1 < NT; j += 2) {
        SBAR(); qkt<DQK>(pB0, pB1, K_lds + SHM_K, qr, r32, hi);
        finishSM(pA0, pA1, alA, l_reg, pa0, pa1, pa2, pa3); SBAR();
        SLOAD(SO, (j + SD) * 64); SBAR();
        pv_d0(o, vb0, pa0, pa1, pa2, pa3); partialSM(pB0, pB1, m_reg, mnB, alB, C, thr_raw);
        __syncthreads(); SWAIT(); SWRITE(0, SE);
        RESC(alB); __syncthreads();
        SBAR(); qkt<DQK>(pA0, pA1, K_lds, qr, r32, hi);
        finishSM(pB0, pB1, alB, l_reg, pa0, pa1, pa2, pa3); SBAR();
        if (SD == 1 || j + 3 < NT) SLOAD(SE, (j + 1 + SD) * 64); SBAR();
        pv_d0(o, vb0 + SHM_V, pa0, pa1, pa2, pa3); partialSM(pA0, pA1, m_reg, mnA, alA, C, thr_raw);
        __syncthreads(); SWAIT(); SWRITE(1, SO);
        RESC(alA); __syncthreads();
    }
    SBAR(); qkt<DQK>(pB0, pB1, K_lds + SHM_K, qr, r32, hi);
    finishSM(pA0, pA1, alA, l_reg, pa0, pa1, pa2, pa3); SBAR();
    pv_d0(o, vb0, pa0, pa1, pa2, pa3); partialSM(pB0, pB1, m_reg, mnB, alB, C, thr_raw);
    __syncthreads(); RESC(alB);
    finishSM(pB0, pB1, alB, l_reg, pa0, pa1, pa2, pa3); SBAR();
    pv_d0(o, vb0 + SHM_V, pa0, pa1, pa2, pa3);
    if (hi == 0) li_l[r32] = l_reg; asm volatile("s_waitcnt lgkmcnt(0)" ::: "memory");
    float rli[16];
#pragma unroll
    for (int r = 0; r < 16; ++r) rli[r] = __builtin_amdgcn_rcpf(li_l[crow(r, hi)]);
    bf16_t* Ow = Ob + (size_t)(wid * 32) * DM;
#pragma unroll
    for (int r = 0; r < 16; ++r) { const int orow = crow(r, hi);
#pragma unroll
        for (int d0 = 0; d0 < 4; ++d0) Ow[(size_t)orow * DM + d0 * 32 + r32] = f2bf(o[d0][r] * rli[r]); }
#undef SLOAD
#undef SWRITE
#undef SWAIT
#undef RESC
}

template <int DQK> __device__ __forceinline__ void qkt_x(const char* qx, f32x16& p0, f32x16& p1, const char* Ks, const bf16x8* qr, int r32, int hi) {
    p0 = f32x16{}; p1 = f32x16{};
#pragma unroll
    for (int d0 = 0; d0 < DQK / 16; ++d0) { const int cb = (d0 * 16 + hi * 8) * 2;
        const bf16x8 b0 = *reinterpret_cast<const bf16x8*>(Ks + kswz<DQK>(r32, cb));
        const bf16x8 b1 = *reinterpret_cast<const bf16x8*>(Ks + kswz<DQK>(32 + r32, cb));
        const bf16x8 q = d0 < 8 ? qr[d0 < 8 ? d0 : 0] : *reinterpret_cast<const bf16x8*>(qx + (d0 - 8) * 8192);
        p0 = __builtin_amdgcn_mfma_f32_32x32x16_bf16(b0, q, p0, 0, 0, 0);
        p1 = __builtin_amdgcn_mfma_f32_32x32x16_bf16(b1, q, p1, 0, 0, 0); }
}
template <int DQK, int LDQ, int LDK, int LDV>
__device__ __forceinline__ void attn_simple(const bf16_t* __restrict__ Qb, const int qr_off, const bf16_t* __restrict__ Kn, const bf16_t* __restrict__ Kr, const bf16_t* __restrict__ Vp,
                                            const int split, const int rlat, const int rctx, bf16_t* __restrict__ Ob, const int seq, const float C, const float thr_raw, char* lds) {
    constexpr int ND0 = DQK / 16, KCH = DQK / 64;
    constexpr int SHM_V = 64 * 128 * 2, SHM_K = 64 * DQK * 2;
    const int tid = otid(), wid = __builtin_amdgcn_readfirstlane(tid >> 6), lane = tid & 63, r32 = lane & 31, hi = lane >> 5;
    char* V_lds = lds; char* K_lds = lds + 2 * SHM_V;
    LAS unsigned char* ldsl = (LAS unsigned char*)(uintptr_t)lds;
    float* wsl = (float*)(lds + 2 * SHM_V + 2 * SHM_K) + wid * 64; float* li_l = wsl; float* al_l = wsl + 32;
    float m_reg = -1e30f, l_reg = 0; f32x16 o[4] = {}; bf16x8 qr[ND0];
    const bf16_t* Qw = Qb + (size_t)(wid * 32 + r32) * LDQ + hi * 8;
#pragma unroll
    for (int d0 = 0; d0 < ND0; ++d0) qr[d0] = *reinterpret_cast<const bf16x8*>(Qw + (d0 < 8 ? d0 * 16 : qr_off + (d0 - 8) * 16));
    int voff[2], koff[KCH];
#pragma unroll
    for (int i = 0; i < 2; ++i) { const int L = (tid + 512 * i) * 16, sub = L >> 9, within = L & 511; const int kk = (sub >> 2) * 8 + (within >> 6), c = (sub & 3) * 32 + ((within & 63) >> 1);
        const int k = (kk & ~0xC) | ((kk & 4) << 1) | ((kk & 8) >> 1); voff[i] = k * LDV + c; }
#pragma unroll
    for (int i = 0; i < KCH; ++i) { const int L = (tid + 512 * i) * 16, row = L / (DQK * 2), cb = (L % (DQK * 2)) ^ ((row & 7) << 4), col = cb >> 1;
        koff[i] = (DQK == 128 || col < 128) ? row * LDK + col : -(row * 64 + col - 128) - 1; }
    const int vb0 = (int)(uintptr_t)V_lds + v_rd_base(lane);
#define STAGE(b, k0) do { const int _row0 = (k0) < split ? rlat + (k0) : rctx + (k0) - split; \
    _Pragma("unroll") for (int _i = 0; _i < 2; ++_i) __builtin_amdgcn_global_load_lds((const unsigned*)(Vp + (size_t)_row0 * LDV + voff[_i]), (LAS unsigned*)(ldsl + (b) * SHM_V + wid * 1024 + _i * 8192), 16, 0, 0); \
    _Pragma("unroll") for (int _i = 0; _i < KCH; ++_i) { const bf16_t* _g = (koff[_i] >= 0) ? Kn + (size_t)_row0 * LDK + koff[_i] : Kr + (size_t)_row0 * 64 + (-koff[_i] - 1); \
        __builtin_amdgcn_global_load_lds((const unsigned*)_g, (LAS unsigned*)(ldsl + 2 * SHM_V + (b) * SHM_K + wid * 1024 + _i * 8192), 16, 0, 0); } } while (0)
    const int NT = seq / 64;
    STAGE(0, 0); asm volatile("s_waitcnt vmcnt(0)" ::: "memory"); __syncthreads();
    for (int j = 0; j < NT; ++j) {
        const int buf = j & 1;
        if (j + 1 < NT) STAGE(buf ^ 1, (j + 1) * 64);
        f32x16 p0, p1; float mn, al; bf16x8 pa0, pa1, pa2, pa3;
        SBAR(); qkt<DQK>(p0, p1, K_lds + buf * SHM_K, qr, r32, hi);
        partialSM(p0, p1, m_reg, mn, al, C, thr_raw);
        if (__any(al < 1.f)) { if (hi == 0) al_l[r32] = al; asm volatile("s_waitcnt lgkmcnt(0)" ::: "memory");
#pragma unroll
            for (int d = 0; d < 4; ++d)
#pragma unroll
                for (int r = 0; r < 16; ++r) o[d][r] *= al_l[crow(r, hi)]; }
        finishSM(p0, p1, al, l_reg, pa0, pa1, pa2, pa3); SBAR();
        pv_d0(o, vb0 + buf * SHM_V, pa0, pa1, pa2, pa3);
        asm volatile("s_waitcnt vmcnt(0)" ::: "memory");
        __syncthreads();
    }
    if (hi == 0) li_l[r32] = l_reg; asm volatile("s_waitcnt lgkmcnt(0)" ::: "memory");
    float rli[16];
#pragma unroll
    for (int r = 0; r < 16; ++r) rli[r] = __builtin_amdgcn_rcpf(li_l[crow(r, hi)]);
    bf16_t* Ow = Ob + (size_t)(wid * 32) * DM;
#pragma unroll
    for (int r = 0; r < 16; ++r) { const int orow = crow(r, hi);
#pragma unroll
        for (int d0 = 0; d0 < 4; ++d0) Ow[(size_t)orow * DM + d0 * 32 + r32] = f2bf(o[d0][r] * rli[r]); }
#undef STAGE
}

template <int DQK, int LDQ, int LDK, int LDV>
__device__ __forceinline__ void attn_pipe(const bf16_t* __restrict__ Qb, const int qr_off, const bf16_t* __restrict__ Kn, const bf16_t* __restrict__ Kr, const bf16_t* __restrict__ Vp,
                                          const int split, const int rlat, const int rctx, bf16_t* __restrict__ Ob, const int seq, const float C, const float thr_raw, char* lds) {
    constexpr int ND0 = 8, KCH = DQK / 64;
    constexpr int SHM_V = 64 * 128 * 2, SHM_K = 64 * DQK * 2;
    const int tid = otid(), wid = __builtin_amdgcn_readfirstlane(tid >> 6), lane = tid & 63, r32 = lane & 31, hi = lane >> 5;
    char* V_lds = lds; char* K_lds = lds + 3 * SHM_V;
    LAS unsigned char* ldsl = (LAS unsigned char*)(uintptr_t)lds;
    float* wsl = (float*)(lds + 3 * SHM_V + 3 * SHM_K) + wid * 64; float* li_l = wsl; float* al_l = wsl + 32;
    char* qx_lds = lds + 3 * SHM_V + 3 * SHM_K + 2048 + tid * 16;
    float m_reg = -1e30f, l_reg = 0; f32x16 o[4] = {}; bf16x8 qr[ND0];
    const bf16_t* Qw = Qb + (size_t)(wid * 32 + r32) * LDQ + hi * 8;
#pragma unroll
    for (int d0 = 0; d0 < ND0; ++d0) qr[d0] = *reinterpret_cast<const bf16x8*>(Qw + d0 * 16);
    if constexpr (DQK == 192) {
#pragma unroll
        for (int e = 0; e < 4; ++e) *reinterpret_cast<bf16x8*>(qx_lds + e * 8192) = *reinterpret_cast<const bf16x8*>(Qw + qr_off + e * 16); }
    int voff[2], koff[KCH];
#pragma unroll
    for (int i = 0; i < 2; ++i) { const int L = (tid + 512 * i) * 16, sub = L >> 9, within = L & 511; const int kk = (sub >> 2) * 8 + (within >> 6), c = (sub & 3) * 32 + ((within & 63) >> 1);
        const int k = (kk & ~0xC) | ((kk & 4) << 1) | ((kk & 8) >> 1); voff[i] = k * LDV + c; }
#pragma unroll
    for (int i = 0; i < KCH; ++i) { const int L = (tid + 512 * i) * 16, row = L / (DQK * 2), cb = (L % (DQK * 2)) ^ ((row & 7) << 4), col = cb >> 1;
        koff[i] = (DQK == 128 || col < 128) ? row * LDK + col : -(row * 64 + col - 128) - 1; }
    const int vb0 = (int)(uintptr_t)V_lds + v_rd_base(lane);
#define STAGE(b, k0) do { const int _row0 = (k0) < split ? rlat + (k0) : rctx + (k0) - split; \
    _Pragma("unroll") for (int _i = 0; _i < 2; ++_i) __builtin_amdgcn_global_load_lds((const unsigned*)(Vp + (size_t)_row0 * LDV + voff[_i]), (LAS unsigned*)(ldsl + (b) * SHM_V + wid * 1024 + _i * 8192), 16, 0, 0); \
    _Pragma("unroll") for (int _i = 0; _i < KCH; ++_i) { const bf16_t* _g = (koff[_i] >= 0) ? Kn + (size_t)_row0 * LDK + koff[_i] : Kr + (size_t)_row0 * 64 + (-koff[_i] - 1); \
        __builtin_amdgcn_global_load_lds((const unsigned*)_g, (LAS unsigned*)(ldsl + 3 * SHM_V + (b) * SHM_K + wid * 1024 + _i * 8192), 16, 0, 0); } } while (0)
#define RESC(a) do { if (__any((a) < 1.f)) { if (hi == 0) al_l[r32] = (a); asm volatile("s_waitcnt lgkmcnt(0)" ::: "memory"); \
    _Pragma("unroll") for (int d = 0; d < 4; ++d) _Pragma("unroll") for (int r = 0; r < 16; ++r) o[d][r] *= al_l[crow(r, hi)]; } } while (0)
    f32x16 pA0, pA1, pB0, pB1; float mnA, mnB, alA, alB; bf16x8 pa0, pa1, pa2, pa3; const int NT = seq / 64;
    STAGE(0, 0); STAGE(1, 64); asm volatile("s_waitcnt vmcnt(0)" ::: "memory"); __syncthreads();
    qkt_x<DQK>(qx_lds, pA0, pA1, K_lds, qr, r32, hi); partialSM(pA0, pA1, m_reg, mnA, alA, C, thr_raw);
    STAGE(2, 128);
    int bp = 0, bc = 1, bn = 2;
#define HALF(c0, c1, mnc, alc, p0_, p1_, alp, j_) do { \
    SBAR(); qkt_x<DQK>(qx_lds, c0, c1, K_lds + bc * SHM_K, qr, r32, hi); \
    finishSM(p0_, p1_, alp, l_reg, pa0, pa1, pa2, pa3); SBAR(); \
    pv_d0(o, vb0 + bp * SHM_V, pa0, pa1, pa2, pa3); partialSM(c0, c1, m_reg, mnc, alc, C, thr_raw); \
    asm volatile("s_waitcnt vmcnt(0)" ::: "memory"); __syncthreads(); \
    if ((j_) + 2 < NT) STAGE(bp, ((j_) + 2) * 64); \
    RESC(alc); \
    { const int _t = bp; bp = bc; bc = bn; bn = _t; } } while (0)
    for (int j = 1; j + 1 < NT; j += 2) {
        HALF(pB0, pB1, mnB, alB, pA0, pA1, alA, j);
        HALF(pA0, pA1, mnA, alA, pB0, pB1, alB, j + 1);
    }
    SBAR(); qkt_x<DQK>(qx_lds, pB0, pB1, K_lds + bc * SHM_K, qr, r32, hi);
    finishSM(pA0, pA1, alA, l_reg, pa0, pa1, pa2, pa3); SBAR();
    pv_d0(o, vb0 + bp * SHM_V, pa0, pa1, pa2, pa3); partialSM(pB0, pB1, m_reg, mnB, alB, C, thr_raw);
    RESC(alB);
    finishSM(pB0, pB1, alB, l_reg, pa0, pa1, pa2, pa3); SBAR();
    pv_d0(o, vb0 + bc * SHM_V, pa0, pa1, pa2, pa3);
    if (hi == 0) li_l[r32] = l_reg; asm volatile("s_waitcnt lgkmcnt(0)" ::: "memory");
    float rli[16];
#pragma unroll
    for (int r = 0; r < 16; ++r) rli[r] = __builtin_amdgcn_rcpf(li_l[crow(r, hi)]);
    bf16_t* Ow = Ob + (size_t)(wid * 32) * DM;
#pragma unroll
    for (int r = 0; r < 16; ++r) { const int orow = crow(r, hi);
#pragma unroll
        for (int d0 = 0; d0 < 4; ++d0) Ow[(size_t)orow * DM + d0 * 32 + r32] = f2bf(o[d0][r] * rli[r]); }
#undef STAGE
#undef RESC
#undef HALF
}

__device__ __forceinline__ int srccol(int type, int r) {
    if (type == 0) return r;
    if (type == 1) return r < INW ? r : -1;
    if (type == 2) { const int pn = r >> 8, rem = r & 255; const int j = 128 * pn + 64 * (rem >> 7) + 16 * ((rem >> 5) & 3) + (rem & 15); return ((rem >> 4) & 1) * FH + j; }
    return r < 512 ? 192 * (r >> 7) + (r & 127) : 192 * ((r - 512) >> 6) + 128 + ((r - 512) & 63);
}
struct TItem { const float* src; bf16_t* dst; int K, Nsrc, type, r0, k0; };
constexpr int TT_FIN = 172 * 16, TT_FOUT = 32 * 43, TT_WIN = 80 * 16, TT_WOUT = 32 * 16, TT_UQ = 12 * 4, TT_UKV = 16 * 2;
constexpr int TT_LAYER = 2 * TT_FIN + 2 * TT_FOUT + TT_WIN + TT_WOUT + TT_UQ + TT_UKV;
constexpr int N_GEMV = 288;
__device__ __forceinline__ TItem titem_decode(const Params& p, int item) {
    const int l = item / TT_LAYER; int t = item % TT_LAYER;
    TItem it; int nrt;
    unsigned char* ws = p.ws;
    if (t < TT_FIN) { it.src = p.in[6] + (size_t)l * DM * 2 * FH; it.dst = (bf16_t*)(ws + WS_W1IN + l * SZ_WFIN); it.K = DM; it.Nsrc = 2 * FH; nrt = 172; it.type = 2; }
    else if ((t -= TT_FIN) < TT_FIN) { it.src = p.in[18] + (size_t)l * DM * 2 * FH; it.dst = (bf16_t*)(ws + WS_W2IN + l * SZ_WFIN); it.K = DM; it.Nsrc = 2 * FH; nrt = 172; it.type = 2; }
    else if ((t -= TT_FIN) < TT_FOUT) { it.src = p.in[7] + (size_t)l * FH * DM; it.dst = (bf16_t*)(ws + WS_W1OUT + l * SZ_WFOUT); it.K = FH; it.Nsrc = DM; nrt = 32; it.type = 0; }
    else if ((t -= TT_FOUT) < TT_FOUT) { it.src = p.in[19] + (size_t)l * FH * DM; it.dst = (bf16_t*)(ws + WS_W2OUT + l * SZ_WFOUT); it.K = FH; it.Nsrc = DM; nrt = 32; it.type = 0; }
    else if ((t -= TT_FOUT) < TT_WIN) { it.src = p.in[8] + (size_t)l * DM * INW; it.dst = (bf16_t*)(ws + WS_WIN + l * SZ_WIN); it.K = DM; it.Nsrc = INW; nrt = 80; it.type = 1; }
    else if ((t -= TT_WIN) < TT_WOUT) { it.src = p.in[11] + (size_t)l * DM * DM; it.dst = (bf16_t*)(ws + WS_WOUT + l * SZ_WOUT); it.K = DM; it.Nsrc = DM; nrt = 32; it.type = 0; }
    else if ((t -= TT_WOUT) < TT_UQ) { it.src = p.in[9] + (size_t)l * 512 * 768; it.dst = (bf16_t*)(ws + WS_WUQ + l * SZ_WUQ); it.K = 512; it.Nsrc = 768; nrt = 12; it.type = 3; }
    else { t -= TT_UQ; it.src = p.in[10] + (size_t)l * 256 * 1024; it.dst = (bf16_t*)(ws + WS_WUKV + l * SZ_WUKV); it.K = 256; it.Nsrc = 1024; nrt = 16; it.type = 0; }
    it.r0 = (t % nrt) * 64; it.k0 = (t / nrt) * 128;
    return it;
}
__device__ __forceinline__ void titem_load(const TItem& it, int tid, f32x4 (&v)[4]) {
    const int r4 = tid & 15, kp = tid >> 4;
    const int sc = srccol(it.type, it.r0 + 4 * r4);
#pragma unroll
    for (int i = 0; i < 4; ++i) { const int kk = 64 * (i >> 1) + 2 * kp + (i & 1);
        v[i] = sc >= 0 ? __builtin_nontemporal_load((const f32x4*)(it.src + (size_t)(it.k0 + kk) * it.Nsrc + sc)) : (f32x4){0.f, 0.f, 0.f, 0.f}; }
}
__device__ __forceinline__ void titem_store(const TItem& it, int tid, const f32x4 (&v)[4], bf16_t* Tb) {
    unsigned* T = (unsigned*)Tb;
    const int r4 = tid & 15, kp = tid >> 4;
#pragma unroll
    for (int h = 0; h < 2; ++h)
#pragma unroll
        for (int j = 0; j < 4; ++j) T[(4 * r4 + j) * 65 + 32 * h + kp] = cvt_pk_bf16(v[2 * h][j], v[2 * h + 1][j]);
    __syncthreads();
#pragma unroll
    for (int i = 0; i < 2; ++i) { const int c = tid + 512 * i, row = c >> 4, k8 = (c & 15) * 8;
        const unsigned* tp = T + row * 65 + 4 * (c & 15);
        const u32x4 w = {tp[0], tp[1], tp[2], tp[3]};
        *(u32x4*)(it.dst + (size_t)(it.r0 + row) * it.K + it.k0 + k8) = w; }
}
__device__ __forceinline__ int tset_item(int l, int which, int i) {
    if (which == 0) return l * TT_LAYER + 2 * TT_FIN + 2 * TT_FOUT + i;
    const int bin = (which == 1) ? 0 : TT_FIN, bout = 2 * TT_FIN + ((which == 1) ? 0 : TT_FOUT);
    return l * TT_LAYER + (i < TT_FIN ? bin + i : bout + i - TT_FIN);
}
__device__ __forceinline__ void transpose_set(const Params& p, int l, int which, int start0, int stride, char* lds, int lo4 = 0, int hi4 = 4) {
    const int nall = (which == 0) ? TT_WIN + TT_WOUT + TT_UQ + TT_UKV : TT_FIN + TT_FOUT;
    const int n = (nall * hi4) / 4, start = (nall * lo4) / 4 + start0;
    const int tid = otid();
    if (start >= n) return;
    TItem c0 = titem_decode(p, tset_item(l, which, start)), c1 = c0;
    f32x4 v0[4], v1[4], v2[4];
    titem_load(c0, tid, v0);
    if (start + stride < n) { c1 = titem_decode(p, tset_item(l, which, start + stride)); titem_load(c1, tid, v1); }
    int buf = 0;
    for (int i = start; i < n; i += stride) {
        TItem c2 = c1;
        if (i + 2 * stride < n) { c2 = titem_decode(p, tset_item(l, which, i + 2 * stride)); titem_load(c2, tid, v2); }
        titem_store(c0, tid, v0, (bf16_t*)(lds + buf * 17408));
        buf ^= 1; c0 = c1; c1 = c2;
#pragma unroll
        for (int q = 0; q < 4; ++q) { v0[q] = v1[q]; v1[q] = v2[q]; }
    }
    __syncthreads();
}
__device__ __forceinline__ void gemv_item(const Params& p, int job, char* lds, bool first) {
    const int l = job / 144, cb = job % 144;
    const int tid = otid();
    float* sc = (float*)lds;
    float* red = (float*)(lds + 40960);
    if (first) {
        for (int e = tid; e < 5 * DM; e += 512) { const int v = e >> 11, kk = e & 2047;
            const float c = v < 4 ? p.in[1][v * DM + kk] : p.in[3][kk];
            sc[e] = c * __builtin_amdgcn_rcpf(1.f + __builtin_amdgcn_exp2f(-c * LOG2E)); }
        __syncthreads();
    }
    const int c4 = tid & 31, ksub = tid >> 5;
    const float* wp = p.in[4] + ((size_t)l * DM + ksub * 128) * MODW + cb * 128 + c4 * 4;
    f32x4 acc[5];
#pragma unroll
    for (int v = 0; v < 5; ++v) acc[v] = (f32x4){0.f, 0.f, 0.f, 0.f};
#pragma unroll 1
    for (int i0 = 0; i0 < 128; i0 += 8) {
        f32x4 w[8];
#pragma unroll
        for (int i = 0; i < 8; ++i) w[i] = __builtin_nontemporal_load((const f32x4*)(wp + (size_t)(i0 + i) * MODW));
#pragma unroll
        for (int i = 0; i < 8; ++i)
#pragma unroll
            for (int v = 0; v < 5; ++v) acc[v] += w[i] * sc[v * DM + ksub * 128 + i0 + i];
    }
#pragma unroll
    for (int v = 0; v < 5; ++v) *(f32x4*)(red + (ksub * 5 + v) * 128 + c4 * 4) = acc[v];
    __syncthreads();
    float* M = (float*)(p.ws + WS_MOD) + (size_t)l * 5 * MODW + cb * 128;
    for (int e = tid; e < 640; e += 512) { const int v = e >> 7, cc = e & 127;
        float sacc = p.in[5][l * MODW + cb * 128 + cc];
#pragma unroll
        for (int ks = 0; ks < 16; ++ks) sacc += red[(ks * 5 + v) * 128 + cc];
        M[(size_t)v * MODW + cc] = sacc; }
    __syncthreads();
}
__device__ __forceinline__ void sincos_acc(double a, float& s, float& c) {
    const double k = rint(a * 0.63661977236758134308);
    double r = fma(-k, 1.57079632679489655800e+00, a); r = fma(-k, 6.12323399573676603587e-17, r);
    const double r2 = r * r;
    double sp = r * (1.0 + r2 * (-1.0 / 6 + r2 * (1.0 / 120 + r2 * (-1.0 / 5040 + r2 * (1.0 / 362880 + r2 * (-1.0 / 39916800 + r2 * (1.0 / 6227020800.0)))))));
    double cp = 1.0 + r2 * (-0.5 + r2 * (1.0 / 24 + r2 * (-1.0 / 720 + r2 * (1.0 / 40320 + r2 * (-1.0 / 3628800 + r2 * (1.0 / 479001600 + r2 * (-1.0 / 87178291200.0)))))));
    const int q = ((int)k) & 3;
    const double ss = (q == 0) ? sp : (q == 1) ? cp : (q == 2) ? -sp : -cp;
    const double cc = (q == 0) ? cp : (q == 1) ? -sp : (q == 2) ? -cp : sp;
    s = (float)ss; c = (float)cc;
}
__device__ __forceinline__ void rope_tables(const Params& p) {
    float* tab = (float*)(p.ws + WS_ROPE);
    for (int e = otid(); e < 3072; e += 512) {
        int pos, l; double base; float *cp, *sp;
        if (e < 2048) { pos = e >> 5; l = e & 31; base = 0.7498942093324559; cp = tab + e; sp = tab + 2048 + e; }
        else { const int f = e - 2048; pos = f >> 4; l = f & 15; base = 0.5623413251903491; cp = tab + 4096 + f; sp = tab + 5120 + f; }
        double fr = 1.0; for (int i = 0; i < l; ++i) fr *= base;
        const float ang = (float)pos * (float)fr;
        float s, c; sincos_acc((double)ang, s, c); *cp = c; *sp = s;
    }
}

__device__ __forceinline__ void norm_phase(float* __restrict__ X, bf16_t* __restrict__ H, const float* __restrict__ modl, int shiftIdx, int scaleIdx, int nrows, const float* __restrict__ PART, const float* __restrict__ XLAT) {
    const int tid_ = otid(); const int lane = tid_ & 63, gw = blockIdx.x * 8 + (tid_ >> 6), nw = gridDim.x * 8;
    for (int row = gw; row < nrows; row += nw) {
        float* xr = X + (size_t)row * DM;
        const float* xs = (XLAT != nullptr && row < NLAT) ? XLAT + (size_t)row * DM : xr;
        f32x4 x[8]; float ss = 0.f;
#pragma unroll
        for (int i = 0; i < 8; ++i) x[i] = *(const f32x4*)(xs + (i * 64 + lane) * 4);
        if (PART != nullptr && row >= NLAT) {
#pragma unroll
            for (int s = 0; s < 8; ++s) { f32x4 pt[8];
#pragma unroll
                for (int i = 0; i < 8; ++i) pt[i] = *(const f32x4*)(PART + ((size_t)s * NCTX + (row - NLAT)) * DM + (i * 64 + lane) * 4);
#pragma unroll
                for (int i = 0; i < 8; ++i) x[i] += pt[i]; }
#pragma unroll
            for (int i = 0; i < 8; ++i) *(f32x4*)(xr + (i * 64 + lane) * 4) = x[i];
        }
#pragma unroll
        for (int i = 0; i < 8; ++i) ss += x[i][0] * x[i][0] + x[i][1] * x[i][1] + x[i][2] * x[i][2] + x[i][3] * x[i][3];
        ss = wave_sum(ss);
        const float r = rsqrtf(ss * (1.f / DM) + EPS);
        const int v = row < NLAT ? (row >> 11) : 4;
        const float* sh = modl + (size_t)v * MODW + shiftIdx * DM; const float* scl = modl + (size_t)v * MODW + scaleIdx * DM;
#pragma unroll
        for (int i = 0; i < 8; ++i) { const int c = (i * 64 + lane) * 4; const f32x4 s4 = *(const f32x4*)(sh + c), c4 = *(const f32x4*)(scl + c);
            const f32x4 h = x[i] * r * (c4 + 1.f) + s4;
            u32x2 w; w.x = cvt_pk_bf16(h[0], h[1]); w.y = cvt_pk_bf16(h[2], h[3]);
            *(u32x2*)(H + (size_t)row * DM + c) = w; }
    }
}
__device__ __forceinline__ void final_phase(const float* __restrict__ X, float* __restrict__ out, const float* __restrict__ gain) {
    const int tid_ = otid(); const int lane = tid_ & 63, gw = blockIdx.x * 8 + (tid_ >> 6), nw = gridDim.x * 8;
    for (int row = gw; row < NLAT; row += nw) {
        const float* xr = X + (size_t)row * DM;
        f32x4 x[8]; float ss = 0.f;
#pragma unroll
        for (int i = 0; i < 8; ++i) { x[i] = *(const f32x4*)(xr + (i * 64 + lane) * 4); ss += x[i][0] * x[i][0] + x[i][1] * x[i][1] + x[i][2] * x[i][2] + x[i][3] * x[i][3]; }
        ss = wave_sum(ss);
        const float r = rsqrtf(ss * (1.f / DM) + EPS);
#pragma unroll
        for (int i = 0; i < 8; ++i) { const int c = (i * 64 + lane) * 4; *(f32x4*)(out + (size_t)row * DM + c) = x[i] * r * *(const f32x4*)(gain + c); }
    }
}
__device__ __forceinline__ void prep_phase(const Params& p, int l) {
    unsigned char* ws = p.ws;
    const bf16_t* P = (const bf16_t*)(ws + WS_GP);
    const float* qg = p.in[12] + l * 128; const float* kg = p.in[13] + l * 128; const float* mqg = p.in[14] + l * 512; const float* mkvg = p.in[15] + l * 256;
    const float* tab = (const float*)(ws + WS_ROPE); const float* cos128 = tab; const float* sin128 = tab + 2048; const float* cos64 = tab + 4096; const float* sin64 = tab + 5120;
    bf16_t* QA = (bf16_t*)(ws + WS_QA); bf16_t* KA = (bf16_t*)(ws + WS_KA); bf16_t* VA = (bf16_t*)(ws + WS_VA);
    bf16_t* CQN = (bf16_t*)(ws + WS_CQN); bf16_t* CKVN = (bf16_t*)(ws + WS_CKVN); bf16_t* KRb = (bf16_t*)(ws + WS_KR);
    const int tid_ = otid(); const int lane = tid_ & 63, gw = blockIdx.x * 8 + (tid_ >> 6), nw = gridDim.x * 8;
    const int half = lane >> 5, li = lane & 31;
    float gq_[4], gk_[4];
#pragma unroll
    for (int q = 0; q < 4; ++q) { gq_[q] = qg[q * 32 + li]; gk_[q] = kg[q * 32 + li]; }
    const f32x4 g0 = *(const f32x4*)(mqg + 4 * lane), g1 = *(const f32x4*)(mqg + 256 + 4 * lane), gkv = *(const f32x4*)(mkvg + 4 * lane);
    const bool wgt = gridDim.x == 256; const int bidp = blockIdx.x, widp = tid_ >> 6;
    const int rbeg = wgt ? (bidp < 128 ? bidp * 20 : 2560 + (bidp - 128) * 52) + widp : gw, rend = wgt ? (bidp < 128 ? bidp * 20 + 20 : 2560 + (bidp - 128) * 52 + 52) : NTOK, rstp = wgt ? 8 : nw;
    for (int row = rbeg; row < rend; row += rstp) {
        const bf16_t* pr = P + (size_t)row * INWP;
        const bool lat = row < NLAT; int b, t, pos;
        if (lat) { b = row >> 11; t = row & 2047; pos = t; } else { const int rr = row - NLAT; b = rr >> 8; t = rr & 255; pos = SEQ + t; }
        const int grow = lat ? (t >> 6) : 0, gcol = lat ? (t & 63) : 0;
        float xh[5][4];
#pragma unroll
        for (int it = 0; it < 5; ++it) { const bf16_t* xp = pr + (it < 4 ? PC_GQ + (2 * it + half) * 128 : PC_GK + half * 128) + li;
#pragma unroll
            for (int q = 0; q < 4; ++q) xh[it][q] = bf2f(xp[q * 32]); }
        const u32x2 v4 = *(const u32x2*)(pr + PC_GV + 4 * lane);
        const f32x4 a0 = bf4_to_f4(*(const u32x2*)(pr + PC_CQ + 4 * lane)), a1 = bf4_to_f4(*(const u32x2*)(pr + PC_CQ + 256 + 4 * lane));
        const f32x4 c0 = bf4_to_f4(*(const u32x2*)(pr + PC_CKV + 4 * lane));
        float xr_[4];
#pragma unroll
        for (int q = 0; q < 4; ++q) xr_[q] = bf2f(pr[PC_KR + q * 16 + (lane & 15)]);
        const float cr = cos128[grow * 32 + li], sr = sin128[grow * 32 + li], cc = cos128[gcol * 32 + li], sn = sin128[gcol * 32 + li];
        const float kc0 = cos64[grow * 16 + (lane & 15)], ks0 = sin64[grow * 16 + (lane & 15)], kc1 = cos64[gcol * 16 + (lane & 15)], ks1 = sin64[gcol * 16 + (lane & 15)];
#pragma unroll
        for (int it = 0; it < 5; ++it) {
            const bool isq = it < 4; const int head = isq ? 2 * it + half : half;
            float x0 = xh[it][0], x1 = xh[it][1], x2 = xh[it][2], x3 = xh[it][3];
            const float ss = half_sum(x0 * x0 + x1 * x1 + x2 * x2 + x3 * x3);
            const float r = rsqrtf(ss * (1.f / 128) + EPS);
            x0 *= r * (isq ? gq_[0] : gk_[0]); x1 *= r * (isq ? gq_[1] : gk_[1]); x2 *= r * (isq ? gq_[2] : gk_[2]); x3 *= r * (isq ? gq_[3] : gk_[3]);
            float y0 = x0, y1 = x1, y2 = x2, y3 = x3;
            if (lat) { y0 = x0 * cr - x1 * sr; y1 = x1 * cr + x0 * sr; y2 = x2 * cc - x3 * sn; y3 = x3 * cc + x2 * sn; }
            bf16_t* dp;
            if (isq) dp = lat ? QA + ((size_t)(b * 8 + head) * SEQ + t) * 128 : QA + (size_t)NLAT * 1024 + ((size_t)(b * 8 + head) * CTXL + t) * 128;
            else dp = KA + ((size_t)(b * 2 + head) * SKV + pos) * 128;
            dp[li] = f2bf(y0); dp[32 + li] = f2bf(y1); dp[64 + li] = f2bf(y2); dp[96 + li] = f2bf(y3);
        }
        *(u32x2*)(VA + ((size_t)(b * 2 + (lane >> 5)) * SKV + pos) * 128 + ((4 * lane) & 127)) = v4;
        { float ss = a0[0] * a0[0] + a0[1] * a0[1] + a0[2] * a0[2] + a0[3] * a0[3] + a1[0] * a1[0] + a1[1] * a1[1] + a1[2] * a1[2] + a1[3] * a1[3];
          ss = wave_sum(ss); const float r = rsqrtf(ss * (1.f / 512) + EPS);
          const f32x4 y0 = a0 * r * g0, y1 = a1 * r * g1; u32x2 w0, w1;
          w0.x = cvt_pk_bf16(y0[0], y0[1]); w0.y = cvt_pk_bf16(y0[2], y0[3]); w1.x = cvt_pk_bf16(y1[0], y1[1]); w1.y = cvt_pk_bf16(y1[2], y1[3]);
          *(u32x2*)(CQN + (size_t)row * 512 + 4 * lane) = w0; *(u32x2*)(CQN + (size_t)row * 512 + 256 + 4 * lane) = w1; }
        { float ss = c0[0] * c0[0] + c0[1] * c0[1] + c0[2] * c0[2] + c0[3] * c0[3];
          ss = wave_sum(ss); const float r = rsqrtf(ss * (1.f / 256) + EPS);
          const f32x4 y0 = c0 * r * gkv; u32x2 w0; w0.x = cvt_pk_bf16(y0[0], y0[1]); w0.y = cvt_pk_bf16(y0[2], y0[3]);
          *(u32x2*)(CKVN + (size_t)row * 256 + 4 * lane) = w0; }
        if (lane < 16) {
            const float x0 = xr_[0], x1 = xr_[1], x2 = xr_[2], x3 = xr_[3];
            float y0 = x0, y1 = x1, y2 = x2, y3 = x3;
            if (lat) { y0 = x0 * kc0 - x1 * ks0; y1 = x1 * kc0 + x0 * ks0; y2 = x2 * kc1 - x3 * ks1; y3 = x3 * kc1 + x2 * ks1; }
            bf16_t* dp = KRb + (size_t)row * 64 + lane; dp[0] = f2bf(y0); dp[16] = f2bf(y1); dp[32] = f2bf(y2); dp[48] = f2bf(y3);
        }
    }
}

__device__ __forceinline__ int hgrn_row(int b, int dir, int ppos) {
    if (dir == 0) return ppos < CTXL ? NLAT + b * CTXL + ppos : b * SEQ + (ppos - CTXL);
    return ppos < CTXL ? NLAT + b * CTXL + (CTXL - 1 - ppos) : b * SEQ + (SEQ - 1 - (ppos - CTXL));
}
constexpr int H1_QS = 0, H1_KD = 17408, H1_KO = 34816, H1_VT = 60928, H1_KET = 79360, H1_AS = 97792, H1_TOT = 107008;
__device__ __forceinline__ void hgrn_chunk_job(const Params& p, int l, int job, char* lds) {
    unsigned char* ws = p.ws;
    const bf16_t* P = (const bf16_t*)(ws + WS_GP);
    const int c = job % NCHUNK, chain = job / NCHUNK, dir = chain & 1, h = (chain >> 1) & 3, b = chain >> 3;
    bf16_t* Qs = (bf16_t*)(lds + H1_QS); bf16_t* Kd = (bf16_t*)(lds + H1_KD); bf16_t* Ko = (bf16_t*)(lds + H1_KO);
    bf16_t* VT = (bf16_t*)(lds + H1_VT); bf16_t* KeT = (bf16_t*)(lds + H1_KET); bf16_t* AS = (bf16_t*)(lds + H1_AS);
    float* tot = (float*)(lds + H1_TOT);
    const int tid = otid(), lane = tid & 63, wid = tid >> 6;
    const int kch = tid & 127, seg = __builtin_amdgcn_readfirstlane(tid >> 7);
    const int p0 = c * 64;
    const int rstep = dir == 0 ? 1 : -1;
    const int rowbase = dir == 0 ? (p0 < CTXL ? NLAT + b * CTXL + p0 : b * SEQ + (p0 - CTXL)) : (p0 < CTXL ? NLAT + b * CTXL + (CTXL - 1 - p0) : b * SEQ + (SEQ - 1 - (p0 - CTXL)));
    float lb = 0.f;
    if (l == 1) { const float a0 = p.in[16][(dir * 2 + 0) * 512 + h * 128 + kch], a1 = p.in[16][(dir * 2 + 1) * 512 + h * 128 + kch]; lb = 1.f / (1.f + expf(a0 - a1)); }
    const int zcol = (dir ? PC_HB : PC_HF) + h * 128 + kch;
    float loc[16], kk[16], qv[16]; float run = 0.f;
    float zin[16], qin[16], vin[16];
#pragma unroll
    for (int j = 0; j < 16; ++j) { const int row = rowbase + rstep * (16 * seg + j);
        const bf16_t* pr = P + (size_t)row * INWP;
        zin[j] = bf2f(pr[zcol]); qin[j] = bf2f(pr[PC_HQ + h * 128 + kch]); vin[j] = bf2f(pr[PC_HI + h * 128 + kch]); }
#pragma unroll
    for (int j = 0; j < 16; ++j) { const int i = 16 * seg + j;
        const float z = zin[j], q = qin[j], vv = vin[j];
        const float e = __builtin_amdgcn_exp2f(-fabsf(z) * LOG2E);
        const float rinv = __builtin_amdgcn_rcpf(1.f + e);
        const float sg = (z >= 0.f ? 1.f : e) * rinv, sgn = (z >= 0.f ? e : 1.f) * rinv;
        float lf2;
        if (l == 0) lf2 = fminf(z, 0.f) * LOG2E - __builtin_amdgcn_logf(1.f + e); else lf2 = __builtin_amdgcn_logf(lb + (1.f - lb) * sg);
        run += lf2; loc[j] = run; kk[j] = (1.f - lb) * sgn; qv[j] = q * 0.08838834764831845f;
        VT[kch * 72 + i] = f2bf(vv); }
    tot[seg * 128 + kch] = run;
    __syncthreads();
    const float t0 = tot[kch], t1 = tot[128 + kch], t2 = tot[256 + kch], t3 = tot[384 + kch];
    const float bseg = (seg > 0 ? t0 : 0.f) + (seg > 1 ? t1 : 0.f) + (seg > 2 ? t2 : 0.f);
    const float after = (seg < 1 ? t1 : 0.f) + (seg < 2 ? t2 : 0.f) + (seg < 3 ? t3 : 0.f);
    bf16_t* qe = (bf16_t*)(ws + WS_QE) + ((size_t)(chain * NCHUNK + c)) * 8192;
#pragma unroll
    for (int j = 0; j < 16; ++j) { const int i = 16 * seg + j;
        Qs[i * 136 + kch] = f2bf(qv[j] * __builtin_amdgcn_exp2f(loc[j]));
        Kd[i * 136 + kch] = f2bf(kk[j] * __builtin_amdgcn_exp2f(-loc[j]));
        KeT[kch * 72 + i] = f2bf(kk[j] * __builtin_amdgcn_exp2f(run - loc[j] + after));
        qe[i * 128 + kch] = f2bf(qv[j] * __builtin_amdgcn_exp2f(bseg + loc[j])); }
    if (seg == 0) ((float*)(ws + WS_DEC))[(size_t)(chain * NCHUNK + c) * 128 + kch] = __builtin_amdgcn_exp2f(t0 + t1 + t2 + t3);
    { float between = 0.f;
#pragma unroll
      for (int ii = 1; ii < 4; ++ii) if (ii > seg) { const int base = (ii == 1) ? 0 : (ii == 2 ? 16 : 48);
#pragma unroll
          for (int j = 0; j < 16; ++j) Ko[(base + 16 * seg + j) * 136 + kch] = f2bf(kk[j] * __builtin_amdgcn_exp2f(run - loc[j] + between));
          between += (ii == 1) ? t1 : (ii == 2 ? t2 : t3); } }
    __syncthreads();
    { const int fr = lane & 15, fq = lane >> 4;
#pragma unroll
      for (int rep = 0; rep < 2; ++rep) { const int blk = wid + 8 * rep; if (blk < 10) {
          const int i = blk < 1 ? 0 : (blk < 3 ? 1 : (blk < 6 ? 2 : 3)); const int j = blk - (i * (i + 1)) / 2;
          const bf16_t* Ap = Qs + (16 * i + fr) * 136 + 8 * fq;
          const bf16_t* Bp = (j == i) ? Kd + (16 * i + fr) * 136 + 8 * fq : Ko + (((i == 1) ? 0 : (i == 2 ? 16 : 48)) + 16 * j + fr) * 136 + 8 * fq;
          f32x4 sc = {0.f, 0.f, 0.f, 0.f};
#pragma unroll
          for (int ks = 0; ks < 4; ++ks) sc = __builtin_amdgcn_mfma_f32_16x16x32_bf16(*(const bf16x8*)(Ap + 32 * ks), *(const bf16x8*)(Bp + 32 * ks), sc, 0, 0, 0);
#pragma unroll
          for (int r = 0; r < 4; ++r) { const int tl = 4 * fq + r;
              AS[(16 * i + tl) * 72 + 16 * j + fr] = f2bf((j < i || fr <= tl) ? sc[r] : 0.f);
              if (j < i) AS[(16 * j + tl) * 72 + 16 * i + fr] = 0; } } } }
    __syncthreads();
    const int r32 = lane & 31, hi = lane >> 5;
    { const int vb = wid >> 1; f32x16 u0 = {}, u1 = {}; const int kb0 = (wid & 1) * 2;
#pragma unroll
      for (int ks = 0; ks < 4; ++ks) {
          const bf16x8 a = *(const bf16x8*)(VT + (32 * vb + r32) * 72 + 16 * ks + 8 * hi);
          const bf16x8 b0 = *(const bf16x8*)(KeT + (32 * kb0 + r32) * 72 + 16 * ks + 8 * hi);
          const bf16x8 b1 = *(const bf16x8*)(KeT + (32 * (kb0 + 1) + r32) * 72 + 16 * ks + 8 * hi);
          u0 = __builtin_amdgcn_mfma_f32_32x32x16_bf16(a, b0, u0, 0, 0, 0);
          u1 = __builtin_amdgcn_mfma_f32_32x32x16_bf16(a, b1, u1, 0, 0, 0); }
      float* st = (float*)(ws + WS_ST) + ((size_t)(chain * NCHUNK + c)) * 16384;
#pragma unroll
      for (int r = 0; r < 16; ++r) { const int v = 32 * vb + crow(r, hi); st[v * 128 + 32 * kb0 + r32] = u0[r]; st[v * 128 + 32 * (kb0 + 1) + r32] = u1[r]; } }
    { const int tb = wid >> 2, vb = wid & 3; f32x16 oo = {};
#pragma unroll
      for (int ks = 0; ks < 4; ++ks) {
          const bf16x8 a = *(const bf16x8*)(AS + (32 * tb + r32) * 72 + 16 * ks + 8 * hi);
          const bf16x8 bb = *(const bf16x8*)(VT + (32 * vb + r32) * 72 + 16 * ks + 8 * hi);
          oo = __builtin_amdgcn_mfma_f32_32x32x16_bf16(a, bb, oo, 0, 0, 0); }
      float* oi = (float*)(ws + WS_OI) + (size_t)dir * NTOK * 512;
#pragma unroll
      for (int r = 0; r < 16; ++r) { const int t = 32 * tb + crow(r, hi); const int row = rowbase + rstep * t;
          oi[(size_t)row * 512 + h * 128 + 32 * vb + r32] = oo[r]; } }
    __syncthreads();
}
__device__ __forceinline__ void hgrn_scan_phase(const Params& p) {
    const float* __restrict__ U = (const float*)(p.ws + WS_ST); bf16_t* __restrict__ S2 = (bf16_t*)(p.ws + WS_ST2); const float* __restrict__ DEC = (const float*)(p.ws + WS_DEC);
    const int nthr = gridDim.x * 512;
    for (int e = blockIdx.x * 512 + otid(); e < NCHAIN * 4096; e += nthr) {
        const int chain = e >> 12, idx4 = (e & 4095) * 4, k4 = idx4 & 127;
        const float* up = U + (size_t)chain * NCHUNK * 16384 + idx4; bf16_t* sp = S2 + (size_t)chain * NCHUNK * 16384 + idx4; const float* dp = DEC + (size_t)chain * NCHUNK * 128 + k4;
        f32x4 S = {0.f, 0.f, 0.f, 0.f};
#pragma unroll 1
        for (int c0 = 0; c0 < NCHUNK; c0 += 12) {
            f32x4 u[12], d[12];
#pragma unroll
            for (int j = 0; j < 12; ++j) { u[j] = __builtin_nontemporal_load((const f32x4*)(up + (size_t)(c0 + j) * 16384)); d[j] = *(const f32x4*)(dp + (c0 + j) * 128); }
#pragma unroll
            for (int j = 0; j < 12; ++j) { u32x2 w; w.x = cvt_pk_bf16(S[0], S[1]); w.y = cvt_pk_bf16(S[2], S[3]);
                *(u32x2*)(sp + (size_t)(c0 + j) * 16384) = w;
                S = d[j] * S + u[j]; }
        }
    }
}
__device__ __forceinline__ void hgrn_out_job(const Params& p, int l, int job, char* lds) {
    unsigned char* ws = p.ws;
    const int j = job % NCHUNK, h = (job / NCHUNK) & 3, b = job / (NCHUNK * 4);
    const int tid = otid(), lane = tid & 63, wid = tid >> 6, r32 = lane & 31, hi = lane >> 5;
    const int tb = wid >> 2, vb = wid & 3;
    const int row0 = j < 4 ? NLAT + b * CTXL + 64 * j : b * SEQ + 64 * (j - 4);
    const float* oi0 = (const float*)(ws + WS_OI); const float* oi1 = oi0 + (size_t)NTOK * 512;
    const bf16_t* P = (const bf16_t*)(ws + WS_GP);
    const int col = h * 128 + 32 * vb + r32;
    float oiv[16], gv[16];
#pragma unroll
    for (int r = 0; r < 16; ++r) { const int row = row0 + 32 * tb + crow(r, hi);
        oiv[r] = oi0[(size_t)row * 512 + col] + oi1[(size_t)row * 512 + col]; gv[r] = bf2f(P[(size_t)row * INWP + PC_HG + col]); }
    f32x16 acc = {};
#pragma unroll
    for (int dir = 0; dir < 2; ++dir) {
        const int chain = (b * 4 + h) * 2 + dir; const int c = dir == 0 ? j : (j < 4 ? 3 - j : 39 - j);
        const bf16_t* qe = (const bf16_t*)(ws + WS_QE) + ((size_t)(chain * NCHUNK + c)) * 8192;
        const bf16_t* st = (const bf16_t*)(ws + WS_ST2) + ((size_t)(chain * NCHUNK + c)) * 16384;
        const int o = 32 * tb + r32; const int i = dir == 0 ? o : 63 - o;
        bf16x8 a[8], bq[8];
#pragma unroll
        for (int ks = 0; ks < 8; ++ks) { a[ks] = *(const bf16x8*)(qe + i * 128 + 16 * ks + 8 * hi); bq[ks] = *(const bf16x8*)(st + (32 * vb + r32) * 128 + 16 * ks + 8 * hi); }
#pragma unroll
        for (int ks = 0; ks < 8; ++ks) acc = __builtin_amdgcn_mfma_f32_32x32x16_bf16(a[ks], bq[ks], acc, 0, 0, 0);
    }
    float* part = (float*)lds;
    float ov[16];
#pragma unroll
    for (int r = 0; r < 16; ++r) { ov[r] = acc[r] + oiv[r];
        const float ssq = half_sum(ov[r] * ov[r]);
        if (r32 == 0) part[vb * 64 + 32 * tb + crow(r, hi)] = ssq; }
    __syncthreads();
    const float gn = p.in[17][l * 128 + 32 * vb + r32];
    bf16_t* MIX = (bf16_t*)(ws + WS_MIX);
#pragma unroll
    for (int r = 0; r < 16; ++r) { const int tr = 32 * tb + crow(r, hi); const int row = row0 + tr;
        const float tot = part[tr] + part[64 + tr] + part[128 + tr] + part[192 + tr];
        const float g = gv[r];
        const float y = ov[r] * rsqrtf(tot * (1.f / 128) + EPS) * gn * g * __builtin_amdgcn_rcpf(1.f + __builtin_amdgcn_exp2f(-g * LOG2E));
        MIX[(size_t)row * DM + 1024 + col] = f2bf(y); }
    __syncthreads();
}

__device__ __forceinline__ void mixer_queue_phase(const Params& p, int l, char* lds) {
    unsigned char* ws = p.ws;
    unsigned* ctr = (unsigned*)(ws + WS_CTRL) + 16 * (l + 1);
    const bool need_ctx = (l == 0);
    const int nH3 = 16 * NCHUNK, total = 384 + nH3 + (need_ctx ? 48 : 0);
    volatile int* slot = (volatile int*)(lds + LDS_ITEM_OFF);
    bf16_t* MIX = (bf16_t*)(ws + WS_MIX);
    const bf16_t* QA = (const bf16_t*)(ws + WS_QA); const bf16_t* KA = (const bf16_t*)(ws + WS_KA); const bf16_t* VA = (const bf16_t*)(ws + WS_VA);
    const bf16_t* UQ = (const bf16_t*)(ws + WS_UQ); const bf16_t* UKV = (const bf16_t*)(ws + WS_UKV); const bf16_t* KR = (const bf16_t*)(ws + WS_KR);
    const float C_A = 0.08838834764831845f * LOG2E, THR_A = 8.f / 0.08838834764831845f;
    const float C_M = 0.07216878364870323f * LOG2E, THR_M = 8.f / 0.07216878364870323f;
    for (;;) {
        if (threadIdx.x == 0) *slot = (int)atomicAdd(ctr, 1u);
        __syncthreads();
        const int item = *slot;
        __syncthreads();
        if (item >= total) break;
        const int nb = 384 + nH3;
        if (item < 128 || item >= nb + 32) {
            const bool isl = item < 128; const int q = isl ? item : item - nb - 32;
            const int b = isl ? q >> 5 : q >> 2, h = isl ? (q >> 3) & 3 : q & 3, qb = isl ? q & 7 : 0;
            const int qrow0 = isl ? b * SEQ + qb * 256 : NLAT + b * CTXL;
            attn_pipe<192, 768, 1024, 1024>(UQ + (size_t)qrow0 * 768 + h * 128, 512 + h * 64 - h * 128, UKV + h * 256, KR, UKV + h * 256 + 128,
                                              isl ? SEQ : 0, b * SEQ, NLAT + b * CTXL, MIX + (size_t)qrow0 * DM + 1536 + h * 128, isl ? SKV : CTXL, C_M, THR_M, lds);
        } else if (item < 384 || item >= nb) {
            const bool isl = item < 384; const int q = isl ? item - 128 : item - nb;
            const int b = isl ? q >> 6 : q >> 3, h = isl ? (q >> 3) & 7 : q & 7, qb = isl ? q & 7 : 0, kvh = h >> 2;
            const bf16_t* Qp = isl ? QA + ((size_t)(b * 8 + h) * SEQ + qb * 256) * 128 : QA + (size_t)NLAT * 1024 + (size_t)(b * 8 + h) * CTXL * 128;
            const int kr0 = (b * 2 + kvh) * SKV;
            bf16_t* Op = MIX + (size_t)(isl ? b * SEQ + qb * 256 : NLAT + b * CTXL) * DM + h * 128;
            attn_pipe<128, 128, 128, 128>(Qp, 0, KA, KA, VA, isl ? SEQ : 0, kr0, kr0 + SEQ, Op, isl ? SKV : CTXL, C_A, THR_A, lds);
        } else {
            const int q = item - 384, bh = q / NCHUNK, jj = q % NCHUNK;
            if (need_ctx || jj >= 4) hgrn_out_job(p, l, bh * NCHUNK + jj, lds);
        }
        __syncthreads();
    }
}

#define XB_TMO      128
#define XB_XCNT(j)  (256  + 64 * (j))
#define XB_XSUB(j)  (1280 + 64 * (j))
#define XB_XGEN(j)  (2304 + 64 * (j))
#define XB_TOP      3328
#define XB_TOPGEN   3392
#define XCD_BAR_WORDS 3456
#define XB_SPIN_CAP (1u << 18)

__device__ __forceinline__ unsigned xb_ld(unsigned* p)              { return __hip_atomic_load(p, __ATOMIC_RELAXED, __HIP_MEMORY_SCOPE_AGENT); }
__device__ __forceinline__ unsigned xb_add(unsigned* p, unsigned v) { return __hip_atomic_fetch_add(p, v, __ATOMIC_RELAXED, __HIP_MEMORY_SCOPE_AGENT); }
__device__ __forceinline__ unsigned xb_xcc_id() { return (unsigned)__builtin_amdgcn_s_getreg((3 << 11) | 20) & 0xFu; }
#define XB_SPIN(cond, bar) do { unsigned _sp = 0; while (cond) { __builtin_amdgcn_s_sleep(1); \
    if ((++_sp & 255u) == 0u) { if (xb_ld(&(bar)[XB_TMO])) break; if (_sp > XB_SPIN_CAP) { atomicAdd(&(bar)[XB_TMO], 1u); break; } } } } while (0)

struct XcdBarrier {
    unsigned* bar; unsigned x;
    volatile LAS unsigned* st;
};

__device__ __forceinline__ XcdBarrier xcd_barrier_post(unsigned* bar, volatile LAS unsigned* st) {
    XcdBarrier b; b.bar = bar; b.x = xb_xcc_id(); b.st = st;
    if (threadIdx.x == 0) (void)xb_add(&bar[XB_XCNT(b.x)], 1u);
    return b;
}
__device__ __forceinline__ void xcd_barrier_complete(unsigned* bar, unsigned x, unsigned& nloc, unsigned& nx) {
    const unsigned G = gridDim.x * gridDim.y * gridDim.z;
    unsigned sum, cnt, mine, sp = 0u;
    for (;;) {
        sum = 0u; cnt = 0u; mine = 0u;
#pragma unroll
        for (unsigned j = 0; j < 16; ++j) { const unsigned c = xb_ld(&bar[XB_XCNT(j)]); sum += c; cnt += (c > 0u) ? 1u : 0u; mine = (j == x) ? c : mine; }
        if (sum == G) break;
        __builtin_amdgcn_s_sleep(1);
        if ((++sp & 255u) == 0u) { if (xb_ld(&bar[XB_TMO])) break; if (sp > XB_SPIN_CAP) { atomicAdd(&bar[XB_TMO], 1u); break; } }
    }
    nloc = mine > 0u ? mine : 1u; nx = cnt > 0u ? cnt : 1u;
}

__device__ __forceinline__ void xcd_barrier(const XcdBarrier& b) {
    asm volatile("s_waitcnt vmcnt(0)" ::: "memory");
    __syncthreads();
    if (threadIdx.x == 0) {
        unsigned* bar = b.bar;
        __builtin_amdgcn_s_waitcnt(0);
        unsigned nloc = b.st[0], nx = b.st[1];
        if (nloc == 0u) { xcd_barrier_complete(bar, b.x, nloc, nx); b.st[0] = nloc; b.st[1] = nx; }
        const unsigned old = xb_add(&bar[XB_XSUB(b.x)], 1u);
        const unsigned gen = old / nloc;
        if (old + 1u == (gen + 1u) * nloc) {
            __builtin_amdgcn_fence(__ATOMIC_RELEASE, "agent");
            asm volatile("s_waitcnt vmcnt(0)" ::: "memory");
            const unsigned og = xb_add(&bar[XB_TOP], 1u);
            const unsigned tg = og / nx;
            if (og + 1u == (tg + 1u) * nx) xb_add(&bar[XB_TOPGEN], 1u);
            else XB_SPIN(xb_ld(&bar[XB_TOPGEN]) == tg, bar);
            __builtin_amdgcn_fence(__ATOMIC_ACQUIRE, "agent");
            xb_add(&bar[XB_XGEN(b.x)], 1u);
            asm volatile("s_waitcnt vmcnt(0)" ::: "memory");
        } else {
            XB_SPIN(xb_ld(&bar[XB_XGEN(b.x)]) == gen, bar);
            __builtin_amdgcn_fence(__ATOMIC_ACQUIRE, "agent");
            asm volatile("s_waitcnt vmcnt(0)" ::: "memory");
        }
    }
    __syncthreads();
}

__device__ __forceinline__ void grid_barrier(unsigned* ctr, unsigned& epoch, const unsigned G) {
    asm volatile("s_waitcnt vmcnt(0) lgkmcnt(0)" ::: "memory");
    __syncthreads();
    epoch += G;
    if (threadIdx.x == 0) {
        __builtin_amdgcn_fence(__ATOMIC_RELEASE, "agent");
        asm volatile("s_waitcnt vmcnt(0)" ::: "memory");
        __hip_atomic_fetch_add(ctr, 1u, __ATOMIC_RELAXED, __HIP_MEMORY_SCOPE_AGENT);
        while (__hip_atomic_load(ctr, __ATOMIC_RELAXED, __HIP_MEMORY_SCOPE_AGENT) < epoch) __builtin_amdgcn_s_sleep(1);
        __builtin_amdgcn_fence(__ATOMIC_ACQUIRE, "agent");
        asm volatile("s_waitcnt vmcnt(0)" ::: "memory");
    }
    __syncthreads();
}

constexpr int NPH = 27;
__global__ void __launch_bounds__(512) fwd_megakernel(Params p) {
    extern __shared__ __attribute__((aligned(16))) unsigned char smem[];
    char* lds = (char*)smem;
    LAS unsigned char* ldsl = (LAS unsigned char*)smem;
    cg::grid_group grid = cg::this_grid();
    unsigned char* ws = p.ws;
    const int tid = threadIdx.x, G = gridDim.x, bid = blockIdx.x;
#define PHASE(n) if (p.ph_lo <= (n) && (n) < p.ph_hi)
#define SYNC(n) do { if (p.ph_lo <= (n) && (n) + 1 < p.ph_hi) { xcd_barrier(xbar); } } while (0)
    volatile LAS unsigned* xst = (volatile LAS unsigned*)(ldsl + LDS_ITEM_OFF + 16);
    if (tid == 0) { xst[0] = 0u; xst[1] = 0u; }
    __syncthreads();
    XcdBarrier xbar = xcd_barrier_post((unsigned*)(ws + WS_BAR), xst);
    if (p.ph_lo < 0) grid.sync();
    float* X = (float*)(ws + WS_X); bf16_t* H = (bf16_t*)(ws + WS_H); bf16_t* Gb = (bf16_t*)(ws + WS_GP); float* Pb = (float*)(ws + WS_GP);
    bf16_t* MIX = (bf16_t*)(ws + WS_MIX);
    const float* MOD = (const float*)(ws + WS_MOD);
    float* PART = (float*)(ws + WS_PART); const bool split_ok = (G == 256);

    PHASE(0) {
        if (bid == 0 && tid < 64) ((unsigned*)(ws + WS_CTRL))[tid] = 0u;
        if (bid == G - 1) rope_tables(p);
        { const size_t nc4 = (size_t)NCTX * DM / 4;
          for (size_t i = (size_t)bid * 512 + tid; i < nc4; i += (size_t)G * 512) ((f32x4*)(X + (size_t)NLAT * DM))[i] = ((const f32x4*)p.in[2])[i]; }
        { bool first = true; for (int it = bid; it < N_GEMV; it += G) { gemv_item(p, it, lds, first); first = false; } }
        if (G == 256) {
            const int nvw = 32 + 224 * 3, w0 = bid < 32 ? bid : 32 + (bid - 32) * 3, nw = bid < 32 ? 1 : 3;
#pragma unroll 1
            for (int w = w0; w < w0 + nw; ++w) { transpose_set(p, 0, 1, w, nvw, lds); transpose_set(p, 0, 0, w, nvw, lds); transpose_set(p, 1, 0, w, nvw, lds); }
        } else { transpose_set(p, 0, 1, bid, G, lds); transpose_set(p, 0, 0, bid, G, lds); transpose_set(p, 1, 0, bid, G, lds); }
        if (G <= 12) { transpose_set(p, 0, 2, bid, G, lds); transpose_set(p, 1, 1, bid, G, lds); transpose_set(p, 1, 2, bid, G, lds); }
    }
    SYNC(0);
#pragma unroll 1
    for (int l = 0; l < 2; ++l) {
        const int pb = 2 + 12 * l;
        const float* modl = MOD + (size_t)l * 5 * MODW;
        const bool last = (l == 1);
        PHASE(pb + 0) norm_phase(X, H, modl, 0, 1, NTOK, (l > 0 && split_ok) ? PART : nullptr, l == 0 ? p.in[0] : nullptr);
        SYNC(pb + 0);
        PHASE(pb + 1) { pg8::Gemm g{H, (const bf16_t*)(ws + WS_W1IN + l * SZ_WFIN), NTOK, 2 * FH, DM}; pg8::StaticOrder S; S.init(g.M, g.N, g.K, G, bid, 0); EpiSwiglu E{Gb}; pg8::gemm_phase(ldsl, g, S, E);
            if (G > 12 && bid >= 12) transpose_set(p, l, 2, bid - 12, G - 12, lds, 0, G == 256 ? 3 : 4); }
        SYNC(pb + 1);
        PHASE(pb + 2) { pg8::Gemm g{Gb, (const bf16_t*)(ws + WS_W1OUT + l * SZ_WFOUT), NTOK, DM, FH}; pg8::StaticOrder S; S.init(g.M, g.N, g.K, G, bid, 1); EpiResid E{X, PART, l == 0 ? p.in[0] : X, modl + 2 * DM, 0.5f}; pg8::gemm_phase(ldsl, g, S, E); }
        SYNC(pb + 2);
        PHASE(pb + 3) norm_phase(X, H, modl, 3, 4, NTOK, split_ok ? PART : nullptr, nullptr);
        SYNC(pb + 3);
        PHASE(pb + 4) { pg8::Gemm g{H, (const bf16_t*)(ws + WS_WIN + l * SZ_WIN), NTOK, INWP, DM}; pg8::StaticOrder S; S.init(g.M, g.N, g.K, G, bid, 0); EpiBf16 E{(bf16_t*)Pb, INWP, -1, nullptr, nullptr}; pg8::gemm_phase(ldsl, g, S, E);
            if (G == 256 && bid >= 208) transpose_set(p, l, 2, bid - 208, 48, lds, 3, 4); }
        SYNC(pb + 4);
        PHASE(pb + 5) {
            prep_phase(p, l);
            for (int job = bid; job < NCHAIN * NCHUNK; job += G) hgrn_chunk_job(p, l, job, lds);
        }
        SYNC(pb + 5);
        PHASE(pb + 6) {
            const float* tab = (const float*)(ws + WS_ROPE);
            { pg8::Gemm g{(const bf16_t*)(ws + WS_CQN), (const bf16_t*)(ws + WS_WUQ + l * SZ_WUQ), NTOK, 768, 512}; pg8::StaticOrder S; S.init(g.M, g.N, g.K, G, bid, 0);
              EpiBf16 E{(bf16_t*)(ws + WS_UQ), 768, 2, tab + 4096, tab + 5120}; pg8::gemm_phase(ldsl, g, S, E); }
            { pg8::Gemm g{(const bf16_t*)(ws + WS_CKVN), (const bf16_t*)(ws + WS_WUKV + l * SZ_WUKV), NTOK, 1024, 256}; pg8::StaticOrder S; S.init(g.M, g.N, g.K, G, (bid + G - 108) % G, 0);
              EpiBf16 E{(bf16_t*)(ws + WS_UKV), 1024, -1, tab + 4096, tab + 5120}; pg8::gemm_phase(ldsl, g, S, E); }
            hgrn_scan_phase(p);
        }
        SYNC(pb + 6);
        PHASE(pb + 7) mixer_queue_phase(p, l, lds);
        SYNC(pb + 7);
        const int Mrows = last ? NLAT : NTOK;
        PHASE(pb + 8) { pg8::Gemm g{MIX, (const bf16_t*)(ws + WS_WOUT + l * SZ_WOUT), Mrows, DM, DM}; pg8::StaticOrder S; S.init(g.M, g.N, g.K, G, bid, 1); EpiResid E{X, PART, X, modl + 5 * DM, 1.0f}; pg8::gemm_phase(ldsl, g, S, E); }
        SYNC(pb + 8);
        PHASE(pb + 9) norm_phase(X, H, modl, 6, 7, Mrows, (!last && split_ok) ? PART : nullptr, nullptr);
        SYNC(pb + 9);
        PHASE(pb + 10) { pg8::Gemm g{H, (const bf16_t*)(ws + WS_W2IN + l * SZ_WFIN), Mrows, 2 * FH, DM}; pg8::StaticOrder S; S.init(g.M, g.N, g.K, G, bid, 0); EpiSwiglu E{Gb}; pg8::gemm_phase(ldsl, g, S, E);
            if (!last && G > 12 && bid >= 12) transpose_set(p, 1, 1, bid - 12, G - 12, lds); }
        SYNC(pb + 10);
        PHASE(pb + 11) { pg8::Gemm g{Gb, (const bf16_t*)(ws + WS_W2OUT + l * SZ_WFOUT), Mrows, DM, FH}; pg8::StaticOrder S; S.init(g.M, g.N, g.K, G, bid, 1); EpiResid E{X, PART, X, modl + 8 * DM, 0.5f}; pg8::gemm_phase(ldsl, g, S, E); }
        SYNC(pb + 11);
    }
    PHASE(26) final_phase(X, p.out, p.in[20]);
#undef PHASE
#undef SYNC
}

extern "C" void kernel_launch(void* const* d_in, const int* in_sizes, int n_in, void* d_out, int out_size, void* d_ws, size_t ws_size, hipStream_t stream) {
    static int grid_blocks = 0;
    if (grid_blocks == 0) {
        if (n_in != 21 || ws_size < WS_END) { fprintf(stderr, "kernel_launch: n_in %d ws %zu (need %zu)\n", n_in, ws_size, (size_t)WS_END); grid_blocks = -1; return; }
        int dev = 0, cus = 0, per_cu = 0;
        (void)hipGetDevice(&dev);
        (void)hipDeviceGetAttribute(&cus, hipDeviceAttributeMultiprocessorCount, dev);
        if (hipFuncSetAttribute((const void*)fwd_megakernel, hipFuncAttributeMaxDynamicSharedMemorySize, LDS_BYTES) != hipSuccess) { fprintf(stderr, "kernel_launch: hipFuncSetAttribute failed\n"); grid_blocks = -1; return; }
        (void)hipOccupancyMaxActiveBlocksPerMultiprocessor(&per_cu, (const void*)fwd_megakernel, 512, LDS_BYTES);
        if (per_cu < 1) { fprintf(stderr, "kernel_launch: occupancy query says %d\n", per_cu); per_cu = 1; }
        grid_blocks = cus * 1;
        (void)hipGetLastError();
    }
    if (grid_blocks < 0) return;
    (void)hipMemsetAsync((char*)d_ws + WS_BAR, 0, 16384, stream);
    Params p{};
    for (int i = 0; i < 21; ++i) p.in[i] = (const float*)d_in[i];
    p.out = (float*)d_out; p.ws = (unsigned char*)d_ws;
#if ONE_LAUNCH
    p.ph_lo = 0; p.ph_hi = NPH;
    void* args[] = {&p};
    hipError_t e = hipLaunchCooperativeKernel((const void*)fwd_megakernel, dim3(grid_blocks), dim3(512), args, LDS_BYTES, stream);
    if (e != hipSuccess) fprintf(stderr, "cooperative launch failed: %s (grid %d)\n", hipGetErrorString(e), grid_blocks);
#else
    for (int ph = 0; ph < NPH; ++ph) { p.ph_lo = ph; p.ph_hi = ph + 1; hipLaunchKernelGGL(fwd_megakernel, dim3(grid_blocks), dim3(512), LDS_BYTES, stream, p); }
#endif
}
```

```cpp
#include <hip/hip_runtime.h>
#include <hip/hip_cooperative_groups.h>
#include <cstdio>
#include <cstdint>
namespace cg = cooperative_groups;

#ifndef ONE_LAUNCH
#define ONE_LAUNCH 1
#endif

typedef unsigned short bf16_t;
typedef short bf16x8 __attribute__((ext_vector_type(8)));
typedef short s16x4 __attribute__((ext_vector_type(4)));
typedef float f32x4 __attribute__((ext_vector_type(4)));
typedef float f32x2 __attribute__((ext_vector_type(2)));
typedef float f32x16 __attribute__((ext_vector_type(16)));
typedef unsigned u32x4 __attribute__((ext_vector_type(4)));
typedef unsigned u32x2 __attribute__((ext_vector_type(2)));
#define LAS __attribute__((address_space(3)))

constexpr int DM = 2048, NB = 4, SEQ = 2048, CTXL = 256, NLAT = NB * SEQ, NCTX = NB * CTXL, NTOK = NLAT + NCTX;
constexpr int FH = 5504, INW = 4928, INWP = 5120, MODW = 9 * DM;
constexpr int SKV = SEQ + CTXL;
constexpr float EPS = 1e-6f;
constexpr float LOG2E = 1.4426950408889634f;
constexpr int PC_GQ = 0, PC_GK = 1024, PC_GV = 1280, PC_HQ = 1536, PC_HI = 2048, PC_HF = 2560, PC_HB = 3072, PC_HG = 3584, PC_CQ = 4096, PC_CKV = 4608, PC_KR = 4864;
constexpr int NCHUNK = 36, NCHAIN = 32;

constexpr size_t al256(size_t x) { return (x + 255) / 256 * 256; }
constexpr size_t WS_CTRL = 0;
constexpr size_t WS_ROPE = 4096;
constexpr size_t WS_MOD = WS_ROPE + 32768;
constexpr size_t WS_MPART = WS_MOD + al256((size_t)2 * 5 * MODW * 4);
constexpr size_t WS_W1IN = WS_MPART + al256((size_t)8 * 2 * 5 * MODW * 4);
constexpr size_t SZ_WFIN = (size_t)2 * FH * DM * 2;
constexpr size_t WS_W2IN = WS_W1IN + 2 * SZ_WFIN;
constexpr size_t WS_W1OUT = WS_W2IN + 2 * SZ_WFIN;
constexpr size_t SZ_WFOUT = (size_t)DM * FH * 2;
constexpr size_t WS_W2OUT = WS_W1OUT + 2 * SZ_WFOUT;
constexpr size_t WS_WIN = WS_W2OUT + 2 * SZ_WFOUT;
constexpr size_t SZ_WIN = (size_t)INWP * DM * 2;
constexpr size_t WS_WOUT = WS_WIN + 2 * SZ_WIN;
constexpr size_t SZ_WOUT = (size_t)DM * DM * 2;
constexpr size_t WS_WUQ = WS_WOUT + 2 * SZ_WOUT;
constexpr size_t SZ_WUQ = (size_t)768 * 512 * 2;
constexpr size_t WS_WUKV = WS_WUQ + 2 * SZ_WUQ;
constexpr size_t SZ_WUKV = (size_t)1024 * 256 * 2;
constexpr size_t WS_X = WS_WUKV + 2 * SZ_WUKV;
constexpr size_t WS_H = WS_X + (size_t)NTOK * DM * 4;
constexpr size_t WS_GP = WS_H + (size_t)NTOK * DM * 2;
constexpr size_t WS_QA = WS_GP + (size_t)NTOK * INWP * 4;
constexpr size_t WS_KA = WS_QA + (size_t)NTOK * 1024 * 2;
constexpr size_t WS_VA = WS_KA + (size_t)NTOK * 256 * 2;
constexpr size_t WS_CQN = WS_VA + (size_t)NTOK * 256 * 2;
constexpr size_t WS_CKVN = WS_CQN + (size_t)NTOK * 512 * 2;
constexpr size_t WS_UQ = WS_CKVN + (size_t)NTOK * 256 * 2;
constexpr size_t WS_UKV = WS_UQ + (size_t)NTOK * 768 * 2;
constexpr size_t WS_KR = WS_UKV + (size_t)NTOK * 1024 * 2;
constexpr size_t WS_MIX = WS_KR + (size_t)NTOK * 64 * 2;
constexpr size_t WS_ST = WS_MIX + (size_t)NTOK * DM * 2;
constexpr size_t WS_DEC = WS_ST + (size_t)NCHAIN * NCHUNK * 16384 * 4;
constexpr size_t WS_QE = WS_DEC + (size_t)NCHAIN * NCHUNK * 128 * 4;
constexpr size_t WS_OI = WS_QE + (size_t)NCHAIN * NCHUNK * 8192 * 2;
constexpr size_t WS_PART = WS_OI + (size_t)2 * NTOK * 512 * 4;
constexpr size_t WS_ST2 = WS_PART + (size_t)8 * NCTX * DM * 4;
constexpr size_t WS_BAR = WS_ST2 + (size_t)NCHAIN * NCHUNK * 16384 * 4;
constexpr size_t WS_END = WS_BAR + 16384;

constexpr int LDS_BYTES = 160 * 1024;
constexpr int LDS_ITEM_OFF = 159 * 1024;

struct Params { const float* in[21]; float* out; unsigned char* ws; int ph_lo, ph_hi; };

__device__ __forceinline__ unsigned cvt_pk_bf16(float lo, float hi) { unsigned r; asm("v_cvt_pk_bf16_f32 %0, %1, %2" : "=v"(r) : "v"(lo), "v"(hi)); return r; }
__device__ __forceinline__ bf16_t f2bf(float x) { return (bf16_t)(cvt_pk_bf16(x, 0.f) & 0xffffu); }
__device__ __forceinline__ float bf2f(bf16_t b) { return __uint_as_float(((unsigned)b) << 16); }
__device__ __forceinline__ f32x4 bf4_to_f4(u32x2 w) { return (f32x4){__uint_as_float(w.x << 16), __uint_as_float(w.x & 0xffff0000u), __uint_as_float(w.y << 16), __uint_as_float(w.y & 0xffff0000u)}; }
__device__ __forceinline__ float wave_sum(float v) {
#pragma unroll
    for (int o = 32; o >= 1; o >>= 1) v += __shfl_xor(v, o, 64);
    return v;
}
__device__ __forceinline__ float half_sum(float v) {
#pragma unroll
    for (int o = 16; o >= 1; o >>= 1) v += __shfl_xor(v, o, 64);
    return v;
}
__device__ __forceinline__ float sigmoidf_(float x) { return 1.f / (1.f + __expf(-x)); }
__device__ __forceinline__ int otid() { int t = threadIdx.x; asm volatile("" : "+v"(t)); return t; }
__device__ __forceinline__ int crow(int r, int hi) { return (r & 3) + 8 * (r >> 2) + 4 * hi; }

namespace pg8 {
constexpr int BM = 256, BK = 64, HALF = 128, HTB = HALF * BK * 2, STAGE_BYTES = 8 * HTB, NXCD = 8, WGM = 8;
__host__ __device__ __forceinline__ int lds_byte(int r, int c) { const int st = (r >> 4) * 2 + (c >> 5), rr = r & 15, cc = c & 31, ob = rr * 64 + cc * 2; return st * 1024 + (ob ^ (((ob >> 9) & 1) << 5)); }
__host__ __device__ __forceinline__ void stage_rc(int b, int& R, int& C) { const int st = b / 1024, sb = b % 1024, swz = sb ^ (((sb >> 9) & 1) << 5); R = (st >> 1) * 16 + swz / 64; C = (st & 1) * 32 + (swz % 64) / 2; }
struct Unit { int pm, pn, k0, nk, part, ks; };
struct Gemm { const bf16_t* A; const bf16_t* Bt; int M, N, K; };
struct StaticOrder {
    int nM, nN, nwg, G, c, nkt, split;
    __device__ __forceinline__ void init(int M, int N, int K, int G_, int c_, int split_) { nM = M / BM; nN = N / BM; G = G_; c = c_; nkt = K / BK; split = (split_ && nM == 36 && nN == 8 && G_ == 256) ? 1 : 0; if (split) nM = 32; nwg = nM * nN; }
    __device__ __forceinline__ void decode(int wg, Unit& u) const {
        int wgid = wg; { const int q = nwg / NXCD, r = nwg % NXCD, xcd = wgid % NXCD, off = wgid / NXCD; wgid = (xcd < r ? xcd * (q + 1) : r * (q + 1) + (xcd - r) * q) + off; }
        const int nig = WGM * nN, gid = wgid / nig, fm = gid * WGM, gsz = (nM - fm) < WGM ? (nM - fm) : WGM;
        u.pm = fm + ((wgid % nig) % gsz); u.pn = (wgid % nig) / gsz;
    }
    __device__ __forceinline__ bool next(int i, Unit& u) const {
        const long L = (long)i * G + c;
        if (L < nwg) { decode((int)L, u); u.k0 = 0; u.nk = nkt; u.part = 0; u.ks = 0; return true; }
        if (!split || i != 1) return false;
        const int j = c, t = j >> 3, s = j & 7;
        u.pm = 32 + (t >> 3); u.pn = t & 7;
        const int npair = nkt >> 1, base = npair >> 3, rem = npair & 7;
        const int p0 = s * base + (s < rem ? s : rem), np = base + (s < rem ? 1 : 0);
        u.k0 = 2 * p0; u.nk = 2 * np; u.part = 1; u.ks = s; return true;
    }
};

template <class Epi>
__device__ __forceinline__ void gemm_phase(LAS unsigned char* lds, const Gemm g, const StaticOrder S, const Epi E) {
    const int tid = otid(), wid = __builtin_amdgcn_readfirstlane(tid >> 6), lane = tid & 63, wr = wid >> 2, wc = wid & 3, fr = lane & 15, fq = lane >> 4;
    const int K = g.K;
    unsigned voffA[2];
#pragma unroll
    for (int i = 0; i < 2; ++i) { int R, C; stage_rc(tid * 16 + i * 8192, R, C); voffA[i] = (unsigned)(R * K + C) * 2u; }
    const size_t kstep = (size_t)(BK * 2);
    const size_t hstep = (size_t)HALF * K * 2;
    const size_t tstep = 2 * hstep;
    const unsigned ldsw = (unsigned)wid * 1024u;
    const int aoff = lds_byte(wr * 64 + fr, fq * 8), boff = lds_byte(wc * 32 + fr, fq * 8);
#define PG8_SA(b, h) (((b) * 2 + (h)) * HTB)
#define PG8_SB(b, h) ((4 + (b) * 2 + (h)) * HTB)
#define PG8_STAGE(bufoff, gbase, voff) do { _Pragma("unroll") for (int _i = 0; _i < 2; ++_i) \
        __builtin_amdgcn_global_load_lds((const unsigned*)((const char*)(gbase) + (voff)[_i]), (LAS unsigned*)(lds + (bufoff) + ldsw + _i * 8192), 16, 0, 0); } while (0)
#define PG8_LDA(dst, b, h) do { _Pragma("unroll") for (int m = 0; m < 4; ++m) _Pragma("unroll") for (int k = 0; k < 2; ++k) dst[m][k] = *(const LAS bf16x8*)(lds + PG8_SA(b, h) + aoff + m * 2048 + k * 1024); } while (0)
#define PG8_LDB(dst, b, h) do { _Pragma("unroll") for (int n = 0; n < 2; ++n) _Pragma("unroll") for (int k = 0; k < 2; ++k) dst[n][k] = *(const LAS bf16x8*)(lds + PG8_SB(b, h) + boff + n * 2048 + k * 1024); } while (0)
#define PG8_MMA(ai, bj, At, Bt) do { __builtin_amdgcn_s_setprio(1); _Pragma("unroll") for (int m = 0; m < 4; ++m) _Pragma("unroll") for (int n = 0; n < 2; ++n) _Pragma("unroll") for (int k = 0; k < 2; ++k) \
        acc[ai][bj][m][n] = __builtin_amdgcn_mfma_f32_16x16x32_bf16(Bt[n][k], At[m][k], acc[ai][bj][m][n], 0, 0, 0); __builtin_amdgcn_s_setprio(0); } while (0)
#define PG8_WAIT_V(n) asm volatile("s_waitcnt vmcnt(" #n ")" ::: "memory")
#define PG8_WAIT_L(n) asm volatile("s_waitcnt lgkmcnt(" #n ")" ::: "memory")
#define PG8_BAR __builtin_amdgcn_s_barrier()
#define PG8_SCHED __builtin_amdgcn_sched_barrier(0)
    Unit cur, nxt; int ui = 0;
    if (!S.next(0, cur)) return;
    f32x4 acc[2][2][4][2];
#pragma unroll
    for (int a = 0; a < 2; ++a)
#pragma unroll
        for (int b = 0; b < 2; ++b)
#pragma unroll
            for (int m = 0; m < 4; ++m)
#pragma unroll
                for (int n = 0; n < 2; ++n) acc[a][b][m][n] = (f32x4){0.f, 0.f, 0.f, 0.f};
    bf16x8 At[4][2], B0[2][2], B1[2][2];
    const char* cA = (const char*)g.A + (size_t)cur.pm * tstep + (size_t)cur.k0 * kstep; const char* cB = (const char*)g.Bt + (size_t)cur.pn * tstep + (size_t)cur.k0 * kstep;
    PG8_STAGE(PG8_SB(0, 0), cB, voffA); PG8_STAGE(PG8_SA(0, 0), cA, voffA); PG8_STAGE(PG8_SB(0, 1), cB + hstep, voffA); PG8_STAGE(PG8_SA(0, 1), cA + hstep, voffA);
    if (wr == 1) PG8_BAR;
    PG8_WAIT_V(4); PG8_BAR;
    PG8_STAGE(PG8_SB(1, 0), cB + kstep, voffA); PG8_STAGE(PG8_SA(1, 0), cA + kstep, voffA); PG8_STAGE(PG8_SB(1, 1), cB + hstep + kstep, voffA);
    PG8_WAIT_V(6); PG8_BAR;
    for (;;) {
        const bool has_next = S.next(ui + 1, nxt);
        const char* nA = has_next ? (const char*)g.A + (size_t)nxt.pm * tstep + (size_t)nxt.k0 * kstep : cA; const char* nB = has_next ? (const char*)g.Bt + (size_t)nxt.pn * tstep + (size_t)nxt.k0 * kstep : cB;
        const int nt = cur.nk;
        for (int t = 0; t < nt; t += 2) {
            const bool last = (t == nt - 2);
            const char* a1 = cA + (size_t)(t + 1) * kstep;
            const char* a2 = last ? nA : cA + (size_t)(t + 2) * kstep; const char* b2 = last ? nB : cB + (size_t)(t + 2) * kstep;
            const char* a3 = a2 + kstep; const char* b3 = b2 + kstep;
            PG8_LDB(B0, 0, 0); PG8_SCHED; PG8_LDA(At, 0, 0); PG8_STAGE(PG8_SA(1, 1), a1 + hstep, voffA);
            PG8_WAIT_L(8); PG8_BAR; PG8_WAIT_L(0); PG8_MMA(0, 0, At, B0); PG8_BAR; PG8_SCHED;
            PG8_LDB(B1, 0, 1); PG8_STAGE(PG8_SB(0, 0), b2, voffA);
            PG8_BAR; PG8_WAIT_L(0); PG8_MMA(0, 1, At, B1); PG8_BAR;
            PG8_LDA(At, 0, 1); PG8_STAGE(PG8_SA(0, 0), a2, voffA);
            PG8_BAR; PG8_WAIT_L(0); PG8_MMA(1, 0, At, B0); PG8_BAR; PG8_SCHED;
            PG8_STAGE(PG8_SB(0, 1), b2 + hstep, voffA);
            PG8_WAIT_V(6); PG8_BAR; PG8_MMA(1, 1, At, B1); PG8_BAR;
            PG8_LDB(B0, 1, 0); PG8_SCHED; PG8_LDA(At, 1, 0); PG8_STAGE(PG8_SA(0, 1), a2 + hstep, voffA);
            PG8_WAIT_L(8); PG8_BAR; PG8_WAIT_L(0); PG8_MMA(0, 0, At, B0); PG8_BAR; PG8_SCHED;
            PG8_LDB(B1, 1, 1); PG8_STAGE(PG8_SB(1, 0), b3, voffA);
            PG8_BAR; PG8_WAIT_L(0); PG8_MMA(0, 1, At, B1); PG8_BAR;
            PG8_LDA(At, 1, 1); PG8_STAGE(PG8_SA(1, 0), a3, voffA);
            PG8_BAR; PG8_WAIT_L(0); PG8_MMA(1, 0, At, B0); PG8_BAR; PG8_SCHED;
            PG8_STAGE(PG8_SB(1, 1), b3 + hstep, voffA);
            PG8_WAIT_V(6); PG8_BAR; PG8_MMA(1, 1, At, B1); PG8_BAR;
        }
        E(acc, cur, wr, wc, fr, fq);
        if (!has_next) break;
#pragma unroll
        for (int a = 0; a < 2; ++a)
#pragma unroll
            for (int b = 0; b < 2; ++b)
#pragma unroll
                for (int m = 0; m < 4; ++m)
#pragma unroll
                    for (int n = 0; n < 2; ++n) acc[a][b][m][n] = (f32x4){0.f, 0.f, 0.f, 0.f};
        cur = nxt; cA = nA; cB = nB; ++ui;
    }
    PG8_WAIT_V(0);
    if (wr == 0) PG8_BAR;
    PG8_BAR;
#undef PG8_SA
#undef PG8_SB
#undef PG8_STAGE
#undef PG8_LDA
#undef PG8_LDB
#undef PG8_MMA
#undef PG8_WAIT_V
#undef PG8_WAIT_L
#undef PG8_BAR
#undef PG8_SCHED
}
}

typedef const f32x4 (&AccRef)[2][2][4][2];

struct EpiSwiglu {
    bf16_t* G;
    __device__ __forceinline__ void operator()(AccRef acc, const pg8::Unit& u, int wr, int wc, int fr, int fq) const {
        const int row0 = u.pm * 256 + wr * 64 + fr, col0 = u.pn * 128 + wc * 16 + 4 * fq;
#pragma unroll
        for (int ai = 0; ai < 2; ++ai)
#pragma unroll
            for (int m = 0; m < 4; ++m) { bf16_t* rowp = G + (size_t)(row0 + ai * 128 + m * 16) * FH + col0;
#pragma unroll
                for (int bj = 0; bj < 2; ++bj) { const f32x4 gq = acc[ai][bj][m][0], uq = acc[ai][bj][m][1]; float v[4];
#pragma unroll
                    for (int i = 0; i < 4; ++i) v[i] = gq[i] * uq[i] * __builtin_amdgcn_rcpf(1.f + __builtin_amdgcn_exp2f(-gq[i] * LOG2E));
                    u32x2 w; w.x = cvt_pk_bf16(v[0], v[1]); w.y = cvt_pk_bf16(v[2], v[3]);
                    *(u32x2*)(rowp + bj * 64) = w; } }
    }
};
struct EpiResid {
    float* X; float* PART; const float* SRC; const float* gate; float coef;
    __device__ __forceinline__ void operator()(AccRef acc, const pg8::Unit& u, int wr, int wc, int fr, int fq) const {
        const int row0 = u.pm * 256 + wr * 64 + fr, col0 = u.pn * 256 + wc * 32 + 4 * fq;
        const int v = u.pm < 32 ? (u.pm >> 3) : 4;
        f32x4 gv[2][2];
#pragma unroll
        for (int bj = 0; bj < 2; ++bj)
#pragma unroll
            for (int n = 0; n < 2; ++n) gv[bj][n] = *(const f32x4*)(gate + (size_t)v * MODW + col0 + bj * 128 + n * 16) * coef;
        const bool part = u.part != 0;
        float* base = part ? PART + ((size_t)u.ks * NCTX - NLAT) * DM : X;
#pragma unroll
        for (int ai = 0; ai < 2; ++ai)
#pragma unroll
            for (int mp = 0; mp < 2; ++mp) {
                f32x4 old[2][2][2];
                if (!part) {
#pragma unroll
                    for (int mm = 0; mm < 2; ++mm)
#pragma unroll
                        for (int bj = 0; bj < 2; ++bj)
#pragma unroll
                            for (int n = 0; n < 2; ++n) old[mm][bj][n] = *(const f32x4*)(SRC + (size_t)(row0 + ai * 128 + (2 * mp + mm) * 16) * DM + col0 + bj * 128 + n * 16);
                }
#pragma unroll
                for (int mm = 0; mm < 2; ++mm)
#pragma unroll
                    for (int bj = 0; bj < 2; ++bj)
#pragma unroll
                        for (int n = 0; n < 2; ++n) { const int m = 2 * mp + mm; const f32x4 d = gv[bj][n] * acc[ai][bj][m][n];
                            *(f32x4*)(base + (size_t)(row0 + ai * 128 + m * 16) * DM + col0 + bj * 128 + n * 16) = part ? d : old[mm][bj][n] + d; }
            }
    }
};
struct EpiF32 {
    float* C; int ldc;
    __device__ __forceinline__ void operator()(AccRef acc, const pg8::Unit& u, int wr, int wc, int fr, int fq) const {
        const int row0 = u.pm * 256 + wr * 64 + fr, col0 = u.pn * 256 + wc * 32 + 4 * fq;
#pragma unroll
        for (int ai = 0; ai < 2; ++ai)
#pragma unroll
            for (int m = 0; m < 4; ++m) { float* rowp = C + (size_t)(row0 + ai * 128 + m * 16) * ldc + col0;
#pragma unroll
                for (int bj = 0; bj < 2; ++bj)
#pragma unroll
                    for (int n = 0; n < 2; ++n) *(f32x4*)(rowp + bj * 128 + n * 16) = acc[ai][bj][m][n]; }
    }
};
struct EpiBf16 {
    bf16_t* O; int ldc; int rope_pn; const float* cos64; const float* sin64;
    __device__ __forceinline__ void operator()(AccRef acc, const pg8::Unit& u, int wr, int wc, int fr, int fq) const {
        const int row0 = u.pm * 256 + wr * 64 + fr, col0 = u.pn * 256 + wc * 32 + 4 * fq;
        const bool rope = (u.pn == rope_pn) && (u.pm < 32);
#pragma unroll
        for (int ai = 0; ai < 2; ++ai)
#pragma unroll
            for (int m = 0; m < 4; ++m) { const int row = row0 + ai * 128 + m * 16; bf16_t* rowp = O + (size_t)row * ldc + col0;
                f32x4 cs = {1.f, 1.f, 1.f, 1.f}, sn = {0.f, 0.f, 0.f, 0.f};
                if (rope) { const int t = row & 2047; const int pos = (wc & 1) ? (t & 63) : (t >> 6); cs = *(const f32x4*)(cos64 + pos * 16 + 4 * fq); sn = *(const f32x4*)(sin64 + pos * 16 + 4 * fq); }
#pragma unroll
                for (int bj = 0; bj < 2; ++bj) {
                    const f32x4 x0 = acc[ai][bj][m][0], x1 = acc[ai][bj][m][1];
                    const f32x4 y0 = x0 * cs - x1 * sn, y1 = x1 * cs + x0 * sn;
                    u32x2 w0, w1; w0.x = cvt_pk_bf16(y0[0], y0[1]); w0.y = cvt_pk_bf16(y0[2], y0[3]); w1.x = cvt_pk_bf16(y1[0], y1[1]); w1.y = cvt_pk_bf16(y1[2], y1[3]);
                    *(u32x2*)(rowp + bj * 128) = w0; *(u32x2*)(rowp + bj * 128 + 16) = w1; } }
    }
};

#define SBAR() __builtin_amdgcn_sched_barrier(0)
template <int OFF> __device__ __forceinline__ s16x4 tr_read(int vb) {
    s16x4 r; asm volatile("ds_read_b64_tr_b16 %0, %1 offset:%2" : "=&v"(r) : "v"(vb), "i"(OFF) : "memory"); return r;
}
__device__ __forceinline__ int v_st(int k, int c) { const int kk = (k & ~0xC) | ((k & 4) << 1) | ((k & 8) >> 1); return ((kk >> 3) * 4 + (c >> 5)) * 512 + ((kk & 7) * 32 + (c & 31)) * 2; }
__device__ __forceinline__ int v_rd_base(int lane) { return ((lane & 3) << 3) | (((lane >> 2) & 3) << 6) | (((lane >> 4) & 1) << 5) | (((lane >> 5) & 1) << 8); }
constexpr int v_rd_off(int d0, int ks, int half) { return d0 * 512 + ks * 4096 + half * 2048; }
template <int D0> __device__ __forceinline__ void pv_one(f32x16& od, int vb, bf16x8 pa0, bf16x8 pa1, bf16x8 pa2, bf16x8 pa3) {
    const s16x4 l0 = tr_read<v_rd_off(D0, 0, 0)>(vb), h0 = tr_read<v_rd_off(D0, 0, 1)>(vb), l1 = tr_read<v_rd_off(D0, 1, 0)>(vb), h1 = tr_read<v_rd_off(D0, 1, 1)>(vb);
    const s16x4 l2 = tr_read<v_rd_off(D0, 2, 0)>(vb), h2 = tr_read<v_rd_off(D0, 2, 1)>(vb), l3 = tr_read<v_rd_off(D0, 3, 0)>(vb), h3 = tr_read<v_rd_off(D0, 3, 1)>(vb);
    asm volatile("s_waitcnt lgkmcnt(0)" ::: "memory"); SBAR();
#define PK(L, H) (bf16x8){L[0], L[1], L[2], L[3], H[0], H[1], H[2], H[3]}
    od = __builtin_amdgcn_mfma_f32_32x32x16_bf16(pa0, PK(l0, h0), od, 0, 0, 0);
    od = __builtin_amdgcn_mfma_f32_32x32x16_bf16(pa1, PK(l1, h1), od, 0, 0, 0);
    od = __builtin_amdgcn_mfma_f32_32x32x16_bf16(pa2, PK(l2, h2), od, 0, 0, 0);
    od = __builtin_amdgcn_mfma_f32_32x32x16_bf16(pa3, PK(l3, h3), od, 0, 0, 0);
#undef PK
}
__device__ __forceinline__ void pv_d0(f32x16* o, int vb, bf16x8 pa0, bf16x8 pa1, bf16x8 pa2, bf16x8 pa3) {
    pv_one<0>(o[0], vb, pa0, pa1, pa2, pa3); pv_one<1>(o[1], vb, pa0, pa1, pa2, pa3); pv_one<2>(o[2], vb, pa0, pa1, pa2, pa3); pv_one<3>(o[3], vb, pa0, pa1, pa2, pa3);
}
__device__ __forceinline__ void partialSM(f32x16& p0, f32x16& p1, float& m_reg, float& mn, float& alpha, const float C, const float thr_raw) {
    float pmax = p0[0];
#pragma unroll
    for (int r = 1; r < 16; ++r) pmax = fmaxf(pmax, p0[r]);
#pragma unroll
    for (int r = 0; r < 16; ++r) pmax = fmaxf(pmax, p1[r]);
    { auto rr = __builtin_amdgcn_permlane32_swap(__float_as_uint(pmax), __float_as_uint(pmax), false, false);
      pmax = fmaxf(__uint_as_float(rr[0]), __uint_as_float(rr[1])); }
    if (__builtin_expect(__all(pmax - m_reg <= thr_raw), 1)) { mn = m_reg; alpha = 1.f; }
    else { mn = fmaxf(m_reg, pmax); alpha = __builtin_amdgcn_exp2f((m_reg - mn) * C); m_reg = mn; }
    const float mnC = -mn * C;
#pragma unroll
    for (int r = 0; r < 16; ++r) p0[r] = fmaf(p0[r], C, mnC);
#pragma unroll
    for (int r = 0; r < 16; ++r) p1[r] = fmaf(p1[r], C, mnC);
#pragma unroll
    for (int r = 0; r < 16; ++r) p0[r] = __builtin_amdgcn_exp2f(p0[r]);
}
__device__ __forceinline__ void finishSM(f32x16& p0, f32x16& p1, float alpha, float& l_reg, bf16x8& pa0, bf16x8& pa1, bf16x8& pa2, bf16x8& pa3) {
#pragma unroll
    for (int r = 0; r < 16; ++r) p1[r] = __builtin_amdgcn_exp2f(p1[r]);
    float ps = 0;
#pragma unroll
    for (int r = 0; r < 16; ++r) ps += p0[r];
#pragma unroll
    for (int r = 0; r < 16; ++r) ps += p1[r];
    { auto rr = __builtin_amdgcn_permlane32_swap(__float_as_uint(ps), __float_as_uint(ps), false, false);
      ps = __uint_as_float(rr[0]) + __uint_as_float(rr[1]); }
    l_reg = l_reg * alpha + ps;
#define PK4(P, BASE, OUT) do { unsigned a0 = cvt_pk_bf16(P[BASE + 0], P[BASE + 1]), a1 = cvt_pk_bf16(P[BASE + 2], P[BASE + 3]);   \
    unsigned b0 = cvt_pk_bf16(P[BASE + 4], P[BASE + 5]), b1 = cvt_pk_bf16(P[BASE + 6], P[BASE + 7]);                              \
    auto r0 = __builtin_amdgcn_permlane32_swap(a0, b0, false, false); auto r1 = __builtin_amdgcn_permlane32_swap(a1, b1, false, false); \
    u32x4 w = {r0[0], r1[0], r0[1], r1[1]}; OUT = *reinterpret_cast<bf16x8*>(&w); } while (0)
    PK4(p0, 0, pa0); PK4(p0, 8, pa1); PK4(p1, 0, pa2); PK4(p1, 8, pa3);
#undef PK4
}
template <int DQK> __device__ __forceinline__ int kswz(int row, int colB) { return row * (DQK * 2) + (colB ^ ((row & 7) << 4)); }
template <int DQK> __device__ __forceinline__ void qkt(f32x16& p0, f32x16& p1, const char* Ks, const bf16x8* qr, int r32, int hi) {
    p0 = f32x16{}; p1 = f32x16{};
#pragma unroll
    for (int d0 = 0; d0 < DQK / 16; ++d0) { const int cb = (d0 * 16 + hi * 8) * 2;
        const bf16x8 b0 = *reinterpret_cast<const bf16x8*>(Ks + kswz<DQK>(r32, cb));
        const bf16x8 b1 = *reinterpret_cast<const bf16x8*>(Ks + kswz<DQK>(32 + r32, cb));
        p0 = __builtin_amdgcn_mfma_f32_32x32x16_bf16(b0, qr[d0], p0, 0, 0, 0);
        p1 = __builtin_amdgcn_mfma_f32_32x32x16_bf16(b1, qr[d0], p1, 0, 0, 0); }
}
template <int DQK, int SD>
__device__ __forceinline__ void attn_body(const bf16_t* __restrict__ Qb, const bf16_t* __restrict__ Kh, const bf16_t* __restrict__ Vh,
                                          bf16_t* __restrict__ Ob, const int seq, const float C, const float thr_raw, char* lds) {
    constexpr int ND0 = DQK / 16, KCH = DQK / 64  , KPR = DQK / 8  ;
    constexpr int SHM_V = 64 * 128 * 2, SHM_K = 64 * DQK * 2;
    const int tid = otid(), wid = tid >> 6, lane = tid & 63, r32 = lane & 31, hi = lane >> 5;
    char* V_lds = lds; char* K_lds = lds + 2 * SHM_V;
    float* wsl = (float*)(lds + 2 * SHM_V + 2 * SHM_K) + wid * 64; float* li_l = wsl; float* al_l = wsl + 32;
    float m_reg = -1e30f, l_reg = 0; f32x16 o[4] = {}; bf16x8 qr[ND0];
    const bf16_t* Qw = Qb + (size_t)(wid * 32 + r32) * DQK + hi * 8;
#pragma unroll
    for (int d0 = 0; d0 < ND0; ++d0) qr[d0] = *reinterpret_cast<const bf16x8*>(Qw + d0 * 16);
    const int sr = tid >> 4, sc = (tid & 15) * 8, vst0 = v_st(sr, sc), vst1 = v_st(32 + sr, sc);
    int krow[KCH], kcol[KCH];
#pragma unroll
    for (int i = 0; i < KCH; ++i) { const int cid = tid + 512 * i; krow[i] = cid / KPR; kcol[i] = (cid % KPR) * 8; }
    const int vb0 = (int)(uintptr_t)V_lds + v_rd_base(lane);
    bf16x8 svs0[SD], svs1[SD], sks[SD][KCH]; constexpr int SE = 0, SO = SD - 1;
#define SLOAD(i, k0) do { svs0[i] = *reinterpret_cast<const bf16x8*>(&Vh[(size_t)((k0) + sr) * 128 + sc]); svs1[i] = *reinterpret_cast<const bf16x8*>(&Vh[(size_t)((k0) + 32 + sr) * 128 + sc]); \
    _Pragma("unroll") for (int _c = 0; _c < KCH; ++_c) sks[i][_c] = *reinterpret_cast<const bf16x8*>(&Kh[(size_t)((k0) + krow[_c]) * DQK + kcol[_c]]); } while (0)
#define SWRITE(b, i) do { *(bf16x8*)(V_lds + (b) * SHM_V + vst0) = svs0[i]; *(bf16x8*)(V_lds + (b) * SHM_V + vst1) = svs1[i]; \
    _Pragma("unroll") for (int _c = 0; _c < KCH; ++_c) *(bf16x8*)(K_lds + (b) * SHM_K + kswz<DQK>(krow[_c], kcol[_c] * 2)) = sks[i][_c]; } while (0)
#define SWAIT() do { if constexpr (SD == 1) asm volatile("s_waitcnt vmcnt(0)" ::: "memory"); else if constexpr (KCH == 2) asm volatile("s_waitcnt vmcnt(4)" ::: "memory"); else asm volatile("s_waitcnt vmcnt(5)" ::: "memory"); } while (0)
#define RESC(a) do { if (__any((a) < 1.f)) { if (hi == 0) al_l[r32] = (a); asm volatile("s_waitcnt lgkmcnt(0)" ::: "memory"); \
    _Pragma("unroll") for (int d = 0; d < 4; ++d) _Pragma("unroll") for (int r = 0; r < 16; ++r) o[d][r] *= al_l[crow(r, hi)]; } } while (0)
    f32x16 pA0, pA1, pB0, pB1; float mnA, mnB, alA, alB; bf16x8 pa0, pa1, pa2, pa3; const int NT = seq / 64;
    SLOAD(SE, 0); asm volatile("s_waitcnt vmcnt(0)" ::: "memory"); SWRITE(0, SE); __syncthreads();
    qkt<DQK>(pA0, pA1, K_lds, qr, r32, hi); partialSM(pA0, pA1, m_reg, mnA, alA, C, thr_raw);
    SLOAD(SO, 64); if constexpr (SD == 2) { if (2 < NT) SLOAD(SE, 128); }
    SWAIT(); SWRITE(1, SO); __syncthreads();
    for (int j = 1; j + 1 < NT; j += 2) {
        SBAR(); qkt<DQK>(pB0, pB1, K_lds + SHM_K, qr, r32, hi);
        finishSM(pA0, pA1, alA, l_reg, pa0, pa1, pa2, pa3); SBAR();
        SLOAD(SO, (j + SD) * 64); SBAR();
        pv_d0(o, vb0, pa0, pa1, pa2, pa3); partialSM(pB0, pB1, m_reg, mnB, alB, C, thr_raw);
        __syncthreads(); SWAIT(); SWRITE(0, SE);
        RESC(alB); __syncthreads();
        SBAR(); qkt<DQK>(pA0, pA1, K_lds, qr, r32, hi);
        finishSM(pB0, pB1, alB, l_reg, pa0, pa1, pa2, pa3); SBAR();
        if (SD == 1 || j + 3 < NT) SLOAD(SE, (j + 1 + SD) * 64); SBAR();
        pv_d0(o, vb0 + SHM_V, pa0, pa1, pa2, pa3); partialSM(pA0, pA1, m_reg, mnA, alA, C, thr_raw);
        __syncthreads(); SWAIT(); SWRITE(1, SO);
        RESC(alA); __syncthreads();
    }
    SBAR(); qkt<DQK>(pB0, pB1, K_lds + SHM_K, qr, r32, hi);
    finishSM(pA0, pA1, alA, l_reg, pa0, pa1, pa2, pa3); SBAR();
    pv_d0(o, vb0, pa0, pa1, pa2, pa3); partialSM(pB0, pB1, m_reg, mnB, alB, C, thr_raw);
    __syncthreads(); RESC(alB);
    finishSM(pB0, pB1, alB, l_reg, pa0, pa1, pa2, pa3); SBAR();
    pv_d0(o, vb0 + SHM_V, pa0, pa1, pa2, pa3);
    if (hi == 0) li_l[r32] = l_reg; asm volatile("s_waitcnt lgkmcnt(0)" ::: "memory");
    float rli[16];
#pragma unroll
    for (int r = 0; r < 16; ++r) rli[r] = __builtin_amdgcn_rcpf(li_l[crow(r, hi)]);
    bf16_t* Ow = Ob + (size_t)(wid * 32) * DM;
#pragma unroll
    for (int r = 0; r < 16; ++r) { const int orow = crow(r, hi);
#pragma unroll
        for (int d0 = 0; d0 < 4; ++d0) Ow[(size_t)orow * DM + d0 * 32 + r32] = f2bf(o[d0][r] * rli[r]); }
#undef SLOAD
#undef SWRITE
#undef SWAIT
#undef RESC
}

template <int DQK> __device__ __forceinline__ void qkt_x(const char* qx, f32x16& p0, f32x16& p1, const char* Ks, const bf16x8* qr, int r32, int hi) {
    p0 = f32x16{}; p1 = f32x16{};
#pragma unroll
    for (int d0 = 0; d0 < DQK / 16; ++d0) { const int cb = (d0 * 16 + hi * 8) * 2;
        const bf16x8 b0 = *reinterpret_cast<const bf16x8*>(Ks + kswz<DQK>(r32, cb));
        const bf16x8 b1 = *reinterpret_cast<const bf16x8*>(Ks + kswz<DQK>(32 + r32, cb));
        const bf16x8 q = d0 < 8 ? qr[d0 < 8 ? d0 : 0] : *reinterpret_cast<const bf16x8*>(qx + (d0 - 8) * 8192);
        p0 = __builtin_amdgcn_mfma_f32_32x32x16_bf16(b0, q, p0, 0, 0, 0);
        p1 = __builtin_amdgcn_mfma_f32_32x32x16_bf16(b1, q, p1, 0, 0, 0); }
}
template <int DQK, int LDQ, int LDK, int LDV>
__device__ __forceinline__ void attn_simple(const bf16_t* __restrict__ Qb, const int qr_off, const bf16_t* __restrict__ Kn, const bf16_t* __restrict__ Kr, const bf16_t* __restrict__ Vp,
                                            const int split, const int rlat, const int rctx, bf16_t* __restrict__ Ob, const int seq, const float C, const float thr_raw, char* lds) {
    constexpr int ND0 = DQK / 16, KCH = DQK / 64;
    constexpr int SHM_V = 64 * 128 * 2, SHM_K = 64 * DQK * 2;
    const int tid = otid(), wid = __builtin_amdgcn_readfirstlane(tid >> 6), lane = tid & 63, r32 = lane & 31, hi = lane >> 5;
    char* V_lds = lds; char* K_lds = lds + 2 * SHM_V;
    LAS unsigned char* ldsl = (LAS unsigned char*)(uintptr_t)lds;
    float* wsl = (float*)(lds + 2 * SHM_V + 2 * SHM_K) + wid * 64; float* li_l = wsl; float* al_l = wsl + 32;
    float m_reg = -1e30f, l_reg = 0; f32x16 o[4] = {}; bf16x8 qr[ND0];
    const bf16_t* Qw = Qb + (size_t)(wid * 32 + r32) * LDQ + hi * 8;
#pragma unroll
    for (int d0 = 0; d0 < ND0; ++d0) qr[d0] = *reinterpret_cast<const bf16x8*>(Qw + (d0 < 8 ? d0 * 16 : qr_off + (d0 - 8) * 16));
    int voff[2], koff[KCH];
#pragma unroll
    for (int i = 0; i < 2; ++i) { const int L = (tid + 512 * i) * 16, sub = L >> 9, within = L & 511; const int kk = (sub >> 2) * 8 + (within >> 6), c = (sub & 3) * 32 + ((within & 63) >> 1);
        const int k = (kk & ~0xC) | ((kk & 4) << 1) | ((kk & 8) >> 1); voff[i] = k * LDV + c; }
#pragma unroll
    for (int i = 0; i < KCH; ++i) { const int L = (tid + 512 * i) * 16, row = L / (DQK * 2), cb = (L % (DQK * 2)) ^ ((row & 7) << 4), col = cb >> 1;
        koff[i] = (DQK == 128 || col < 128) ? row * LDK + col : -(row * 64 + col - 128) - 1; }
    const int vb0 = (int)(uintptr_t)V_lds + v_rd_base(lane);
#define STAGE(b, k0) do { const int _row0 = (k0) < split ? rlat + (k0) : rctx + (k0) - split; \
    _Pragma("unroll") for (int _i = 0; _i < 2; ++_i) __builtin_amdgcn_global_load_lds((const unsigned*)(Vp + (size_t)_row0 * LDV + voff[_i]), (LAS unsigned*)(ldsl + (b) * SHM_V + wid * 1024 + _i * 8192), 16, 0, 0); \
    _Pragma("unroll") for (int _i = 0; _i < KCH; ++_i) { const bf16_t* _g = (koff[_i] >= 0) ? Kn + (size_t)_row0 * LDK + koff[_i] : Kr + (size_t)_row0 * 64 + (-koff[_i] - 1); \
        __builtin_amdgcn_global_load_lds((const unsigned*)_g, (LAS unsigned*)(ldsl + 2 * SHM_V + (b) * SHM_K + wid * 1024 + _i * 8192), 16, 0, 0); } } while (0)
    const int NT = seq / 64;
    STAGE(0, 0); asm volatile("s_waitcnt vmcnt(0)" ::: "memory"); __syncthreads();
    for (int j = 0; j < NT; ++j) {
        const int buf = j & 1;
        if (j + 1 < NT) STAGE(buf ^ 1, (j + 1) * 64);
        f32x16 p0, p1; float mn, al; bf16x8 pa0, pa1, pa2, pa3;
        SBAR(); qkt<DQK>(p0, p1, K_lds + buf * SHM_K, qr, r32, hi);
        partialSM(p0, p1, m_reg, mn, al, C, thr_raw);
        if (__any(al < 1.f)) { if (hi == 0) al_l[r32] = al; asm volatile("s_waitcnt lgkmcnt(0)" ::: "memory");
#pragma unroll
            for (int d = 0; d < 4; ++d)
#pragma unroll
                for (int r = 0; r < 16; ++r) o[d][r] *= al_l[crow(r, hi)]; }
        finishSM(p0, p1, al, l_reg, pa0, pa1, pa2, pa3); SBAR();
        pv_d0(o, vb0 + buf * SHM_V, pa0, pa1, pa2, pa3);
        asm volatile("s_waitcnt vmcnt(0)" ::: "memory");
        __syncthreads();
    }
    if (hi == 0) li_l[r32] = l_reg; asm volatile("s_waitcnt lgkmcnt(0)" ::: "memory");
    float rli[16];
#pragma unroll
    for (int r = 0; r < 16; ++r) rli[r] = __builtin_amdgcn_rcpf(li_l[crow(r, hi)]);
    bf16_t* Ow = Ob + (size_t)(wid * 32) * DM;
#pragma unroll
    for (int r = 0; r < 16; ++r) { const int orow = crow(r, hi);
#pragma unroll
        for (int d0 = 0; d0 < 4; ++d0) Ow[(size_t)orow * DM + d0 * 32 + r32] = f2bf(o[d0][r] * rli[r]); }
#undef STAGE
}

template <int DQK, int LDQ, int LDK, int LDV>
__device__ __forceinline__ void attn_pipe(const bf16_t* __restrict__ Qb, const int qr_off, const bf16_t* __restrict__ Kn, const bf16_t* __restrict__ Kr, const bf16_t* __restrict__ Vp,
                                          const int split, const int rlat, const int rctx, bf16_t* __restrict__ Ob, const int seq, const float C, const float thr_raw, char* lds) {
    constexpr int ND0 = 8, KCH = DQK / 64;
    constexpr int SHM_V = 64 * 128 * 2, SHM_K = 64 * DQK * 2;
    const int tid = otid(), wid = __builtin_amdgcn_readfirstlane(tid >> 6), lane = tid & 63, r32 = lane & 31, hi = lane >> 5;
    char* V_lds = lds; char* K_lds = lds + 3 * SHM_V;
    LAS unsigned char* ldsl = (LAS unsigned char*)(uintptr_t)lds;
    float* wsl = (float*)(lds + 3 * SHM_V + 3 * SHM_K) + wid * 64; float* li_l = wsl; float* al_l = wsl + 32;
    char* qx_lds = lds + 3 * SHM_V + 3 * SHM_K + 2048 + tid * 16;
    float m_reg = -1e30f, l_reg = 0; f32x16 o[4] = {}; bf16x8 qr[ND0];
    const bf16_t* Qw = Qb + (size_t)(wid * 32 + r32) * LDQ + hi * 8;
#pragma unroll
    for (int d0 = 0; d0 < ND0; ++d0) qr[d0] = *reinterpret_cast<const bf16x8*>(Qw + d0 * 16);
    if constexpr (DQK == 192) {
#pragma unroll
        for (int e = 0; e < 4; ++e) *reinterpret_cast<bf16x8*>(qx_lds + e * 8192) = *reinterpret_cast<const bf16x8*>(Qw + qr_off + e * 16); }
    int voff[2], koff[KCH];
#pragma unroll
    for (int i = 0; i < 2; ++i) { const int L = (tid + 512 * i) * 16, sub = L >> 9, within = L & 511; const int kk = (sub >> 2) * 8 + (within >> 6), c = (sub & 3) * 32 + ((within & 63) >> 1);
        const int k = (kk & ~0xC) | ((kk & 4) << 1) | ((kk & 8) >> 1); voff[i] = k * LDV + c; }
#pragma unroll
    for (int i = 0; i < KCH; ++i) { const int L = (tid + 512 * i) * 16, row = L / (DQK * 2), cb = (L % (DQK * 2)) ^ ((row & 7) << 4), col = cb >> 1;
        koff[i] = (DQK == 128 || col < 128) ? row * LDK + col : -(row * 64 + col - 128) - 1; }
    const int vb0 = (int)(uintptr_t)V_lds + v_rd_base(lane);
#define STAGE(b, k0) do { const int _row0 = (k0) < split ? rlat + (k0) : rctx + (k0) - split; \
    _Pragma("unroll") for (int _i = 0; _i < 2; ++_i) __builtin_amdgcn_global_load_lds((const unsigned*)(Vp + (size_t)_row0 * LDV + voff[_i]), (LAS unsigned*)(ldsl + (b) * SHM_V + wid * 1024 + _i * 8192), 16, 0, 0); \
    _Pragma("unroll") for (int _i = 0; _i < KCH; ++_i) { const bf16_t* _g = (koff[_i] >= 0) ? Kn + (size_t)_row0 * LDK + koff[_i] : Kr + (size_t)_row0 * 64 + (-koff[_i] - 1); \
        __builtin_amdgcn_global_load_lds((const unsigned*)_g, (LAS unsigned*)(ldsl + 3 * SHM_V + (b) * SHM_K + wid * 1024 + _i * 8192), 16, 0, 0); } } while (0)
#define RESC(a) do { if (__any((a) < 1.f)) { if (hi == 0) al_l[r32] = (a); asm volatile("s_waitcnt lgkmcnt(0)" ::: "memory"); \
    _Pragma("unroll") for (int d = 0; d < 4; ++d) _Pragma("unroll") for (int r = 0; r < 16; ++r) o[d][r] *= al_l[crow(r, hi)]; } } while (0)
    f32x16 pA0, pA1, pB0, pB1; float mnA, mnB, alA, alB; bf16x8 pa0, pa1, pa2, pa3; const int NT = seq / 64;
    STAGE(0, 0); STAGE(1, 64); asm volatile("s_waitcnt vmcnt(0)" ::: "memory"); __syncthreads();
    qkt_x<DQK>(qx_lds, pA0, pA1, K_lds, qr, r32, hi); partialSM(pA0, pA1, m_reg, mnA, alA, C, thr_raw);
    STAGE(2, 128);
    int bp = 0, bc = 1, bn = 2;
#define HALF(c0, c1, mnc, alc, p0_, p1_, alp, j_) do { \
    SBAR(); qkt_x<DQK>(qx_lds, c0, c1, K_lds + bc * SHM_K, qr, r32, hi); \
    finishSM(p0_, p1_, alp, l_reg, pa0, pa1, pa2, pa3); SBAR(); \
    pv_d0(o, vb0 + bp * SHM_V, pa0, pa1, pa2, pa3); partialSM(c0, c1, m_reg, mnc, alc, C, thr_raw); \
    asm volatile("s_waitcnt vmcnt(0)" ::: "memory"); __syncthreads(); \
    if ((j_) + 2 < NT) STAGE(bp, ((j_) + 2) * 64); \
    RESC(alc); \
    { const int _t = bp; bp = bc; bc = bn; bn = _t; } } while (0)
    for (int j = 1; j + 1 < NT; j += 2) {
        HALF(pB0, pB1, mnB, alB, pA0, pA1, alA, j);
        HALF(pA0, pA1, mnA, alA, pB0, pB1, alB, j + 1);
    }
    SBAR(); qkt_x<DQK>(qx_lds, pB0, pB1, K_lds + bc * SHM_K, qr, r32, hi);
    finishSM(pA0, pA1, alA, l_reg, pa0, pa1, pa2, pa3); SBAR();
    pv_d0(o, vb0 + bp * SHM_V, pa0, pa1, pa2, pa3); partialSM(pB0, pB1, m_reg, mnB, alB, C, thr_raw);
    RESC(alB);
    finishSM(pB0, pB1, alB, l_reg, pa0, pa1, pa2, pa3); SBAR();
    pv_d0(o, vb0 + bc * SHM_V, pa0, pa1, pa2, pa3);
    if (hi == 0) li_l[r32] = l_reg; asm volatile("s_waitcnt lgkmcnt(0)" ::: "memory");
    float rli[16];
#pragma unroll
    for (int r = 0; r < 16; ++r) rli[r] = __builtin_amdgcn_rcpf(li_l[crow(r, hi)]);
    bf16_t* Ow = Ob + (size_t)(wid * 32) * DM;
#pragma unroll
    for (int r = 0; r < 16; ++r) { const int orow = crow(r, hi);
#pragma unroll
        for (int d0 = 0; d0 < 4; ++d0) Ow[(size_t)orow * DM + d0 * 32 + r32] = f2bf(o[d0][r] * rli[r]); }
#undef STAGE
#undef RESC
#undef HALF
}

__device__ __forceinline__ int srccol(int type, int r) {
    if (type == 0) return r;
    if (type == 1) return r < INW ? r : -1;
    if (type == 2) { const int pn = r >> 8, rem = r & 255; const int j = 128 * pn + 64 * (rem >> 7) + 16 * ((rem >> 5) & 3) + (rem & 15); return ((rem >> 4) & 1) * FH + j; }
    return r < 512 ? 192 * (r >> 7) + (r & 127) : 192 * ((r - 512) >> 6) + 128 + ((r - 512) & 63);
}
struct TItem { const float* src; bf16_t* dst; int K, Nsrc, type, r0, k0; };
constexpr int TT_FIN = 172 * 16, TT_FOUT = 32 * 43, TT_WIN = 80 * 16, TT_WOUT = 32 * 16, TT_UQ = 12 * 4, TT_UKV = 16 * 2;
constexpr int TT_LAYER = 2 * TT_FIN + 2 * TT_FOUT + TT_WIN + TT_WOUT + TT_UQ + TT_UKV;
constexpr int N_GEMV = 288;
__device__ __forceinline__ TItem titem_decode(const Params& p, int item) {
    const int l = item / TT_LAYER; int t = item % TT_LAYER;
    TItem it; int nrt;
    unsigned char* ws = p.ws;
    if (t < TT_FIN) { it.src = p.in[6] + (size_t)l * DM * 2 * FH; it.dst = (bf16_t*)(ws + WS_W1IN + l * SZ_WFIN); it.K = DM; it.Nsrc = 2 * FH; nrt = 172; it.type = 2; }
    else if ((t -= TT_FIN) < TT_FIN) { it.src = p.in[18] + (size_t)l * DM * 2 * FH; it.dst = (bf16_t*)(ws + WS_W2IN + l * SZ_WFIN); it.K = DM; it.Nsrc = 2 * FH; nrt = 172; it.type = 2; }
    else if ((t -= TT_FIN) < TT_FOUT) { it.src = p.in[7] + (size_t)l * FH * DM; it.dst = (bf16_t*)(ws + WS_W1OUT + l * SZ_WFOUT); it.K = FH; it.Nsrc = DM; nrt = 32; it.type = 0; }
    else if ((t -= TT_FOUT) < TT_FOUT) { it.src = p.in[19] + (size_t)l * FH * DM; it.dst = (bf16_t*)(ws + WS_W2OUT + l * SZ_WFOUT); it.K = FH; it.Nsrc = DM; nrt = 32; it.type = 0; }
    else if ((t -= TT_FOUT) < TT_WIN) { it.src = p.in[8] + (size_t)l * DM * INW; it.dst = (bf16_t*)(ws + WS_WIN + l * SZ_WIN); it.K = DM; it.Nsrc = INW; nrt = 80; it.type = 1; }
    else if ((t -= TT_WIN) < TT_WOUT) { it.src = p.in[11] + (size_t)l * DM * DM; it.dst = (bf16_t*)(ws + WS_WOUT + l * SZ_WOUT); it.K = DM; it.Nsrc = DM; nrt = 32; it.type = 0; }
    else if ((t -= TT_WOUT) < TT_UQ) { it.src = p.in[9] + (size_t)l * 512 * 768; it.dst = (bf16_t*)(ws + WS_WUQ + l * SZ_WUQ); it.K = 512; it.Nsrc = 768; nrt = 12; it.type = 3; }
    else { t -= TT_UQ; it.src = p.in[10] + (size_t)l * 256 * 1024; it.dst = (bf16_t*)(ws + WS_WUKV + l * SZ_WUKV); it.K = 256; it.Nsrc = 1024; nrt = 16; it.type = 0; }
    it.r0 = (t % nrt) * 64; it.k0 = (t / nrt) * 128;
    return it;
}
__device__ __forceinline__ void titem_load(const TItem& it, int tid, f32x4 (&v)[4]) {
    const int r4 = tid & 15, kp = tid >> 4;
    const int sc = srccol(it.type, it.r0 + 4 * r4);
#pragma unroll
    for (int i = 0; i < 4; ++i) { const int kk = 64 * (i >> 1) + 2 * kp + (i & 1);
        v[i] = sc >= 0 ? __builtin_nontemporal_load((const f32x4*)(it.src + (size_t)(it.k0 + kk) * it.Nsrc + sc)) : (f32x4){0.f, 0.f, 0.f, 0.f}; }
}
__device__ __forceinline__ void titem_store(const TItem& it, int tid, const f32x4 (&v)[4], bf16_t* Tb) {
    unsigned* T = (unsigned*)Tb;
    const int r4 = tid & 15, kp = tid >> 4;
#pragma unroll
    for (int h = 0; h < 2; ++h)
#pragma unroll
        for (int j = 0; j < 4; ++j) T[(4 * r4 + j) * 65 + 32 * h + kp] = cvt_pk_bf16(v[2 * h][j], v[2 * h + 1][j]);
    __syncthreads();
#pragma unroll
    for (int i = 0; i < 2; ++i) { const int c = tid + 512 * i, row = c >> 4, k8 = (c & 15) * 8;
        const unsigned* tp = T + row * 65 + 4 * (c & 15);
        const u32x4 w = {tp[0], tp[1], tp[2], tp[3]};
        *(u32x4*)(it.dst + (size_t)(it.r0 + row) * it.K + it.k0 + k8) = w; }
}
__device__ __forceinline__ int tset_item(int l, int which, int i) {
    if (which == 0) return l * TT_LAYER + 2 * TT_FIN + 2 * TT_FOUT + i;
    const int bin = (which == 1) ? 0 : TT_FIN, bout = 2 * TT_FIN + ((which == 1) ? 0 : TT_FOUT);
    return l * TT_LAYER + (i < TT_FIN ? bin + i : bout + i - TT_FIN);
}
__device__ __forceinline__ void transpose_set(const Params& p, int l, int which, int start0, int stride, char* lds, int lo4 = 0, int hi4 = 4) {
    const int nall = (which == 0) ? TT_WIN + TT_WOUT + TT_UQ + TT_UKV : TT_FIN + TT_FOUT;
    const int n = (nall * hi4) / 4, start = (nall * lo4) / 4 + start0;
    const int tid = otid();
    if (start >= n) return;
    TItem c0 = titem_decode(p, tset_item(l, which, start)), c1 = c0;
    f32x4 v0[4], v1[4], v2[4];
    titem_load(c0, tid, v0);
    if (start + stride < n) { c1 = titem_decode(p, tset_item(l, which, start + stride)); titem_load(c1, tid, v1); }
    int buf = 0;
    for (int i = start; i < n; i += stride) {
        TItem c2 = c1;
        if (i + 2 * stride < n) { c2 = titem_decode(p, tset_item(l, which, i + 2 * stride)); titem_load(c2, tid, v2); }
        titem_store(c0, tid, v0, (bf16_t*)(lds + buf * 17408));
        buf ^= 1; c0 = c1; c1 = c2;
#pragma unroll
        for (int q = 0; q < 4; ++q) { v0[q] = v1[q]; v1[q] = v2[q]; }
    }
    __syncthreads();
}
__device__ __forceinline__ void gemv_item(const Params& p, int job, char* lds, bool first) {
    const int l = job / 144, cb = job % 144;
    const int tid = otid();
    float* sc = (float*)lds;
    float* red = (float*)(lds + 40960);
    if (first) {
        for (int e = tid; e < 5 * DM; e += 512) { const int v = e >> 11, kk = e & 2047;
            const float c = v < 4 ? p.in[1][v * DM + kk] : p.in[3][kk];
            sc[e] = c * __builtin_amdgcn_rcpf(1.f + __builtin_amdgcn_exp2f(-c * LOG2E)); }
        __syncthreads();
    }
    const int c4 = tid & 31, ksub = tid >> 5;
    const float* wp = p.in[4] + ((size_t)l * DM + ksub * 128) * MODW + cb * 128 + c4 * 4;
    f32x4 acc[5];
#pragma unroll
    for (int v = 0; v < 5; ++v) acc[v] = (f32x4){0.f, 0.f, 0.f, 0.f};
#pragma unroll 1
    for (int i0 = 0; i0 < 128; i0 += 8) {
        f32x4 w[8];
#pragma unroll
        for (int i = 0; i < 8; ++i) w[i] = __builtin_nontemporal_load((const f32x4*)(wp + (size_t)(i0 + i) * MODW));
#pragma unroll
        for (int i = 0; i < 8; ++i)
#pragma unroll
            for (int v = 0; v < 5; ++v) acc[v] += w[i] * sc[v * DM + ksub * 128 + i0 + i];
    }
#pragma unroll
    for (int v = 0; v < 5; ++v) *(f32x4*)(red + (ksub * 5 + v) * 128 + c4 * 4) = acc[v];
    __syncthreads();
    float* M = (float*)(p.ws + WS_MOD) + (size_t)l * 5 * MODW + cb * 128;
    for (int e = tid; e < 640; e += 512) { const int v = e >> 7, cc = e & 127;
        float sacc = p.in[5][l * MODW + cb * 128 + cc];
#pragma unroll
        for (int ks = 0; ks < 16; ++ks) sacc += red[(ks * 5 + v) * 128 + cc];
        M[(size_t)v * MODW + cc] = sacc; }
    __syncthreads();
}
__device__ __forceinline__ void sincos_acc(double a, float& s, float& c) {
    const double k = rint(a * 0.63661977236758134308);
    double r = fma(-k, 1.57079632679489655800e+00, a); r = fma(-k, 6.12323399573676603587e-17, r);
    const double r2 = r * r;
    double sp = r * (1.0 + r2 * (-1.0 / 6 + r2 * (1.0 / 120 + r2 * (-1.0 / 5040 + r2 * (1.0 / 362880 + r2 * (-1.0 / 39916800 + r2 * (1.0 / 6227020800.0)))))));
    double cp = 1.0 + r2 * (-0.5 + r2 * (1.0 / 24 + r2 * (-1.0 / 720 + r2 * (1.0 / 40320 + r2 * (-1.0 / 3628800 + r2 * (1.0 / 479001600 + r2 * (-1.0 / 87178291200.0)))))));
    const int q = ((int)k) & 3;
    const double ss = (q == 0) ? sp : (q == 1) ? cp : (q == 2) ? -sp : -cp;
    const double cc = (q == 0) ? cp : (q == 1) ? -sp : (q == 2) ? -cp : sp;
    s = (float)ss; c = (float)cc;
}
__device__ __forceinline__ void rope_tables(const Params& p) {
    float* tab = (float*)(p.ws + WS_ROPE);
    for (int e = otid(); e < 3072; e += 512) {
        int pos, l; double base; float *cp, *sp;
        if (e < 2048) { pos = e >> 5; l = e & 31; base = 0.7498942093324559; cp = tab + e; sp = tab + 2048 + e; }
        else { const int f = e - 2048; pos = f >> 4; l = f & 15; base = 0.5623413251903491; cp = tab + 4096 + f; sp = tab + 5120 + f; }
        double fr = 1.0; for (int i = 0; i < l; ++i) fr *= base;
        const float ang = (float)pos * (float)fr;
        float s, c; sincos_acc((double)ang, s, c); *cp = c; *sp = s;
    }
}

__device__ __forceinline__ void norm_phase(float* __restrict__ X, bf16_t* __restrict__ H, const float* __restrict__ modl, int shiftIdx, int scaleIdx, int nrows, const float* __restrict__ PART, const float* __restrict__ XLAT) {
    const int tid_ = otid(); const int lane = tid_ & 63, gw = blockIdx.x * 8 + (tid_ >> 6), nw = gridDim.x * 8;
    for (int row = gw; row < nrows; row += nw) {
        float* xr = X + (size_t)row * DM;
        const float* xs = (XLAT != nullptr && row < NLAT) ? XLAT + (size_t)row * DM : xr;
        f32x4 x[8]; float ss = 0.f;
#pragma unroll
        for (int i = 0; i < 8; ++i) x[i] = *(const f32x4*)(xs + (i * 64 + lane) * 4);
        if (PART != nullptr && row >= NLAT) {
#pragma unroll
            for (int s = 0; s < 8; ++s) { f32x4 pt[8];
#pragma unroll
                for (int i = 0; i < 8; ++i) pt[i] = *(const f32x4*)(PART + ((size_t)s * NCTX + (row - NLAT)) * DM + (i * 64 + lane) * 4);
#pragma unroll
                for (int i = 0; i < 8; ++i) x[i] += pt[i]; }
#pragma unroll
            for (int i = 0; i < 8; ++i) *(f32x4*)(xr + (i * 64 + lane) * 4) = x[i];
        }
#pragma unroll
        for (int i = 0; i < 8; ++i) ss += x[i][0] * x[i][0] + x[i][1] * x[i][1] + x[i][2] * x[i][2] + x[i][3] * x[i][3];
        ss = wave_sum(ss);
        const float r = rsqrtf(ss * (1.f / DM) + EPS);
        const int v = row < NLAT ? (row >> 11) : 4;
        const float* sh = modl + (size_t)v * MODW + shiftIdx * DM; const float* scl = modl + (size_t)v * MODW + scaleIdx * DM;
#pragma unroll
        for (int i = 0; i < 8; ++i) { const int c = (i * 64 + lane) * 4; const f32x4 s4 = *(const f32x4*)(sh + c), c4 = *(const f32x4*)(scl + c);
            const f32x4 h = x[i] * r * (c4 + 1.f) + s4;
            u32x2 w; w.x = cvt_pk_bf16(h[0], h[1]); w.y = cvt_pk_bf16(h[2], h[3]);
            *(u32x2*)(H + (size_t)row * DM + c) = w; }
    }
}
__device__ __forceinline__ void final_phase(const float* __restrict__ X, float* __restrict__ out, const float* __restrict__ gain) {
    const int tid_ = otid(); const int lane = tid_ & 63, gw = blockIdx.x * 8 + (tid_ >> 6), nw = gridDim.x * 8;
    for (int row = gw; row < NLAT; row += nw) {
        const float* xr = X + (size_t)row * DM;
        f32x4 x[8]; float ss = 0.f;
#pragma unroll
        for (int i = 0; i < 8; ++i) { x[i] = *(const f32x4*)(xr + (i * 64 + lane) * 4); ss += x[i][0] * x[i][0] + x[i][1] * x[i][1] + x[i][2] * x[i][2] + x[i][3] * x[i][3]; }
        ss = wave_sum(ss);
        const float r = rsqrtf(ss * (1.f / DM) + EPS);
#pragma unroll
        for (int i = 0; i < 8; ++i) { const int c = (i * 64 + lane) * 4; *(f32x4*)(out + (size_t)row * DM + c) = x[i] * r * *(const f32x4*)(gain + c); }
    }
}
__device__ __forceinline__ void prep_phase(const Params& p, int l) {
    unsigned char* ws = p.ws;
    const bf16_t* P = (const bf16_t*)(ws + WS_GP);
    const float* qg = p.in[12] + l * 128; const float* kg = p.in[13] + l * 128; const float* mqg = p.in[14] + l * 512; const float* mkvg = p.in[15] + l * 256;
    const float* tab = (const float*)(ws + WS_ROPE); const float* cos128 = tab; const float* sin128 = tab + 2048; const float* cos64 = tab + 4096; const float* sin64 = tab + 5120;
    bf16_t* QA = (bf16_t*)(ws + WS_QA); bf16_t* KA = (bf16_t*)(ws + WS_KA); bf16_t* VA = (bf16_t*)(ws + WS_VA);
    bf16_t* CQN = (bf16_t*)(ws + WS_CQN); bf16_t* CKVN = (bf16_t*)(ws + WS_CKVN); bf16_t* KRb = (bf16_t*)(ws + WS_KR);
    const int tid_ = otid(); const int lane = tid_ & 63, gw = blockIdx.x * 8 + (tid_ >> 6), nw = gridDim.x * 8;
    const int half = lane >> 5, li = lane & 31;
    float gq_[4], gk_[4];
#pragma unroll
    for (int q = 0; q < 4; ++q) { gq_[q] = qg[q * 32 + li]; gk_[q] = kg[q * 32 + li]; }
    const f32x4 g0 = *(const f32x4*)(mqg + 4 * lane), g1 = *(const f32x4*)(mqg + 256 + 4 * lane), gkv = *(const f32x4*)(mkvg + 4 * lane);
    struct PrepIn { float xh[5][4]; u32x2 v4; f32x4 a0, a1, c0; float xr_[4]; float cr, sr, cc, sn, kc0, ks0, kc1, ks1; };
    auto load_row = [&](int row, PrepIn& in) {
        const bf16_t* pr = P + (size_t)row * INWP;
        const bool lat = row < NLAT; const int t = lat ? (row & 2047) : ((row - NLAT) & 255);
        const int grow = lat ? (t >> 6) : 0, gcol = lat ? (t & 63) : 0;
#pragma unroll
        for (int it = 0; it < 5; ++it) { const bf16_t* xp = pr + (it < 4 ? PC_GQ + (2 * it + half) * 128 : PC_GK + half * 128) + li;
#pragma unroll
            for (int q = 0; q < 4; ++q) in.xh[it][q] = bf2f(xp[q * 32]); }
        in.v4 = *(const u32x2*)(pr + PC_GV + 4 * lane);
        in.a0 = bf4_to_f4(*(const u32x2*)(pr + PC_CQ + 4 * lane)); in.a1 = bf4_to_f4(*(const u32x2*)(pr + PC_CQ + 256 + 4 * lane));
        in.c0 = bf4_to_f4(*(const u32x2*)(pr + PC_CKV + 4 * lane));
#pragma unroll
        for (int q = 0; q < 4; ++q) in.xr_[q] = bf2f(pr[PC_KR + q * 16 + (lane & 15)]);
        in.cr = cos128[grow * 32 + li]; in.sr = sin128[grow * 32 + li]; in.cc = cos128[gcol * 32 + li]; in.sn = sin128[gcol * 32 + li];
        in.kc0 = cos64[grow * 16 + (lane & 15)]; in.ks0 = sin64[grow * 16 + (lane & 15)]; in.kc1 = cos64[gcol * 16 + (lane & 15)]; in.ks1 = sin64[gcol * 16 + (lane & 15)];
    };
    PrepIn cur, nxt;
    if (gw < NTOK) load_row(gw, cur);
    for (int row = gw; row < NTOK; row += nw) {
        if (row + nw < NTOK) load_row(row + nw, nxt);
        const bool lat = row < NLAT; int b, t, pos;
        if (lat) { b = row >> 11; t = row & 2047; pos = t; } else { const int rr = row - NLAT; b = rr >> 8; t = rr & 255; pos = SEQ + t; }
        const float (&xh)[5][4] = cur.xh; const u32x2 v4 = cur.v4; const f32x4 a0 = cur.a0, a1 = cur.a1, c0 = cur.c0; const float (&xr_)[4] = cur.xr_;
        const float cr = cur.cr, sr = cur.sr, cc = cur.cc, sn = cur.sn, kc0 = cur.kc0, ks0 = cur.ks0, kc1 = cur.kc1, ks1 = cur.ks1;
#pragma unroll
        for (int it = 0; it < 5; ++it) {
            const bool isq = it < 4; const int head = isq ? 2 * it + half : half;
            float x0 = xh[it][0], x1 = xh[it][1], x2 = xh[it][2], x3 = xh[it][3];
            const float ss = half_sum(x0 * x0 + x1 * x1 + x2 * x2 + x3 * x3);
            const float r = rsqrtf(ss * (1.f / 128) + EPS);
            x0 *= r * (isq ? gq_[0] : gk_[0]); x1 *= r * (isq ? gq_[1] : gk_[1]); x2 *= r * (isq ? gq_[2] : gk_[2]); x3 *= r * (isq ? gq_[3] : gk_[3]);
            float y0 = x0, y1 = x1, y2 = x2, y3 = x3;
            if (lat) { y0 = x0 * cr - x1 * sr; y1 = x1 * cr + x0 * sr; y2 = x2 * cc - x3 * sn; y3 = x3 * cc + x2 * sn; }
            bf16_t* dp;
            if (isq) dp = lat ? QA + ((size_t)(b * 8 + head) * SEQ + t) * 128 : QA + (size_t)NLAT * 1024 + ((size_t)(b * 8 + head) * CTXL + t) * 128;
            else dp = KA + ((size_t)(b * 2 + head) * SKV + pos) * 128;
            dp[li] = f2bf(y0); dp[32 + li] = f2bf(y1); dp[64 + li] = f2bf(y2); dp[96 + li] = f2bf(y3);
        }
        *(u32x2*)(VA + ((size_t)(b * 2 + (lane >> 5)) * SKV + pos) * 128 + ((4 * lane) & 127)) = v4;
        { float ss = a0[0] * a0[0] + a0[1] * a0[1] + a0[2] * a0[2] + a0[3] * a0[3] + a1[0] * a1[0] + a1[1] * a1[1] + a1[2] * a1[2] + a1[3] * a1[3];
          ss = wave_sum(ss); const float r = rsqrtf(ss * (1.f / 512) + EPS);
          const f32x4 y0 = a0 * r * g0, y1 = a1 * r * g1; u32x2 w0, w1;
          w0.x = cvt_pk_bf16(y0[0], y0[1]); w0.y = cvt_pk_bf16(y0[2], y0[3]); w1.x = cvt_pk_bf16(y1[0], y1[1]); w1.y = cvt_pk_bf16(y1[2], y1[3]);
          *(u32x2*)(CQN + (size_t)row * 512 + 4 * lane) = w0; *(u32x2*)(CQN + (size_t)row * 512 + 256 + 4 * lane) = w1; }
        { float ss = c0[0] * c0[0] + c0[1] * c0[1] + c0[2] * c0[2] + c0[3] * c0[3];
          ss = wave_sum(ss); const float r = rsqrtf(ss * (1.f / 256) + EPS);
          const f32x4 y0 = c0 * r * gkv; u32x2 w0; w0.x = cvt_pk_bf16(y0[0], y0[1]); w0.y = cvt_pk_bf16(y0[2], y0[3]);
          *(u32x2*)(CKVN + (size_t)row * 256 + 4 * lane) = w0; }
        if (lane < 16) {
            const float x0 = xr_[0], x1 = xr_[1], x2 = xr_[2], x3 = xr_[3];
            float y0 = x0, y1 = x1, y2 = x2, y3 = x3;
            if (lat) { y0 = x0 * kc0 - x1 * ks0; y1 = x1 * kc0 + x0 * ks0; y2 = x2 * kc1 - x3 * ks1; y3 = x3 * kc1 + x2 * ks1; }
            bf16_t* dp = KRb + (size_t)row * 64 + lane; dp[0] = f2bf(y0); dp[16] = f2bf(y1); dp[32] = f2bf(y2); dp[48] = f2bf(y3);
        }
        cur = nxt;
    }
}

__device__ __forceinline__ int hgrn_row(int b, int dir, int ppos) {
    if (dir == 0) return ppos < CTXL ? NLAT + b * CTXL + ppos : b * SEQ + (ppos - CTXL);
    return ppos < CTXL ? NLAT + b * CTXL + (CTXL - 1 - ppos) : b * SEQ + (SEQ - 1 - (ppos - CTXL));
}
constexpr int H1_QS = 0, H1_KD = 17408, H1_KO = 34816, H1_VT = 60928, H1_KET = 79360, H1_AS = 97792, H1_TOT = 107008;
__device__ __forceinline__ void hgrn_chunk_job(const Params& p, int l, int job, char* lds) {
    unsigned char* ws = p.ws;
    const bf16_t* P = (const bf16_t*)(ws + WS_GP);
    const int c = job % NCHUNK, chain = job / NCHUNK, dir = chain & 1, h = (chain >> 1) & 3, b = chain >> 3;
    bf16_t* Qs = (bf16_t*)(lds + H1_QS); bf16_t* Kd = (bf16_t*)(lds + H1_KD); bf16_t* Ko = (bf16_t*)(lds + H1_KO);
    bf16_t* VT = (bf16_t*)(lds + H1_VT); bf16_t* KeT = (bf16_t*)(lds + H1_KET); bf16_t* AS = (bf16_t*)(lds + H1_AS);
    float* tot = (float*)(lds + H1_TOT);
    const int tid = otid(), lane = tid & 63, wid = tid >> 6;
    const int kch = tid & 127, seg = __builtin_amdgcn_readfirstlane(tid >> 7);
    const int p0 = c * 64;
    const int rstep = dir == 0 ? 1 : -1;
    const int rowbase = dir == 0 ? (p0 < CTXL ? NLAT + b * CTXL + p0 : b * SEQ + (p0 - CTXL)) : (p0 < CTXL ? NLAT + b * CTXL + (CTXL - 1 - p0) : b * SEQ + (SEQ - 1 - (p0 - CTXL)));
    float lb = 0.f;
    if (l == 1) { const float a0 = p.in[16][(dir * 2 + 0) * 512 + h * 128 + kch], a1 = p.in[16][(dir * 2 + 1) * 512 + h * 128 + kch]; lb = 1.f / (1.f + expf(a0 - a1)); }
    const int zcol = (dir ? PC_HB : PC_HF) + h * 128 + kch;
    float loc[16], kk[16], qv[16]; float run = 0.f;
    float zin[16], qin[16], vin[16];
#pragma unroll
    for (int j = 0; j < 16; ++j) { const int row = rowbase + rstep * (16 * seg + j);
        const bf16_t* pr = P + (size_t)row * INWP;
        zin[j] = bf2f(pr[zcol]); qin[j] = bf2f(pr[PC_HQ + h * 128 + kch]); vin[j] = bf2f(pr[PC_HI + h * 128 + kch]); }
#pragma unroll
    for (int j = 0; j < 16; ++j) { const int i = 16 * seg + j;
        const float z = zin[j], q = qin[j], vv = vin[j];
        const float e = __builtin_amdgcn_exp2f(-fabsf(z) * LOG2E);
        const float rinv = __builtin_amdgcn_rcpf(1.f + e);
        const float sg = (z >= 0.f ? 1.f : e) * rinv, sgn = (z >= 0.f ? e : 1.f) * rinv;
        float lf2;
        if (l == 0) lf2 = fminf(z, 0.f) * LOG2E - __builtin_amdgcn_logf(1.f + e); else lf2 = __builtin_amdgcn_logf(lb + (1.f - lb) * sg);
        run += lf2; loc[j] = run; kk[j] = (1.f - lb) * sgn; qv[j] = q * 0.08838834764831845f;
        VT[kch * 72 + i] = f2bf(vv); }
    tot[seg * 128 + kch] = run;
    __syncthreads();
    const float t0 = tot[kch], t1 = tot[128 + kch], t2 = tot[256 + kch], t3 = tot[384 + kch];
    const float bseg = (seg > 0 ? t0 : 0.f) + (seg > 1 ? t1 : 0.f) + (seg > 2 ? t2 : 0.f);
    const float after = (seg < 1 ? t1 : 0.f) + (seg < 2 ? t2 : 0.f) + (seg < 3 ? t3 : 0.f);
    bf16_t* qe = (bf16_t*)(ws + WS_QE) + ((size_t)(chain * NCHUNK + c)) * 8192;
#pragma unroll
    for (int j = 0; j < 16; ++j) { const int i = 16 * seg + j;
        Qs[i * 136 + kch] = f2bf(qv[j] * __builtin_amdgcn_exp2f(loc[j]));
        Kd[i * 136 + kch] = f2bf(kk[j] * __builtin_amdgcn_exp2f(-loc[j]));
        KeT[kch * 72 + i] = f2bf(kk[j] * __builtin_amdgcn_exp2f(run - loc[j] + after));
        qe[i * 128 + kch] = f2bf(qv[j] * __builtin_amdgcn_exp2f(bseg + loc[j])); }
    if (seg == 0) ((float*)(ws + WS_DEC))[(size_t)(chain * NCHUNK + c) * 128 + kch] = __builtin_amdgcn_exp2f(t0 + t1 + t2 + t3);
    { float between = 0.f;
#pragma unroll
      for (int ii = 1; ii < 4; ++ii) if (ii > seg) { const int base = (ii == 1) ? 0 : (ii == 2 ? 16 : 48);
#pragma unroll
          for (int j = 0; j < 16; ++j) Ko[(base + 16 * seg + j) * 136 + kch] = f2bf(kk[j] * __builtin_amdgcn_exp2f(run - loc[j] + between));
          between += (ii == 1) ? t1 : (ii == 2 ? t2 : t3); } }
    __syncthreads();
    { const int fr = lane & 15, fq = lane >> 4;
#pragma unroll
      for (int rep = 0; rep < 2; ++rep) { const int blk = wid + 8 * rep; if (blk < 10) {
          const int i = blk < 1 ? 0 : (blk < 3 ? 1 : (blk < 6 ? 2 : 3)); const int j = blk - (i * (i + 1)) / 2;
          const bf16_t* Ap = Qs + (16 * i + fr) * 136 + 8 * fq;
          const bf16_t* Bp = (j == i) ? Kd + (16 * i + fr) * 136 + 8 * fq : Ko + (((i == 1) ? 0 : (i == 2 ? 16 : 48)) + 16 * j + fr) * 136 + 8 * fq;
          f32x4 sc = {0.f, 0.f, 0.f, 0.f};
#pragma unroll
          for (int ks = 0; ks < 4; ++ks) sc = __builtin_amdgcn_mfma_f32_16x16x32_bf16(*(const bf16x8*)(Ap + 32 * ks), *(const bf16x8*)(Bp + 32 * ks), sc, 0, 0, 0);
#pragma unroll
          for (int r = 0; r < 4; ++r) { const int tl = 4 * fq + r;
              AS[(16 * i + tl) * 72 + 16 * j + fr] = f2bf((j < i || fr <= tl) ? sc[r] : 0.f);
              if (j < i) AS[(16 * j + tl) * 72 + 16 * i + fr] = 0; } } } }
    __syncthreads();
    const int r32 = lane & 31, hi = lane >> 5;
    { const int vb = wid >> 1; f32x16 u0 = {}, u1 = {}; const int kb0 = (wid & 1) * 2;
#pragma unroll
      for (int ks = 0; ks < 4; ++ks) {
          const bf16x8 a = *(const bf16x8*)(VT + (32 * vb + r32) * 72 + 16 * ks + 8 * hi);
          const bf16x8 b0 = *(const bf16x8*)(KeT + (32 * kb0 + r32) * 72 + 16 * ks + 8 * hi);
          const bf16x8 b1 = *(const bf16x8*)(KeT + (32 * (kb0 + 1) + r32) * 72 + 16 * ks + 8 * hi);
          u0 = __builtin_amdgcn_mfma_f32_32x32x16_bf16(a, b0, u0, 0, 0, 0);
          u1 = __builtin_amdgcn_mfma_f32_32x32x16_bf16(a, b1, u1, 0, 0, 0); }
      float* st = (float*)(ws + WS_ST) + ((size_t)(chain * NCHUNK + c)) * 16384;
#pragma unroll
      for (int r = 0; r < 16; ++r) { const int v = 32 * vb + crow(r, hi); st[v * 128 + 32 * kb0 + r32] = u0[r]; st[v * 128 + 32 * (kb0 + 1) + r32] = u1[r]; } }
    { const int tb = wid >> 2, vb = wid & 3; f32x16 oo = {};
#pragma unroll
      for (int ks = 0; ks < 4; ++ks) {
          const bf16x8 a = *(const bf16x8*)(AS + (32 * tb + r32) * 72 + 16 * ks + 8 * hi);
          const bf16x8 bb = *(const bf16x8*)(VT + (32 * vb + r32) * 72 + 16 * ks + 8 * hi);
          oo = __builtin_amdgcn_mfma_f32_32x32x16_bf16(a, bb, oo, 0, 0, 0); }
      float* oi = (float*)(ws + WS_OI) + (size_t)dir * NTOK * 512;
#pragma unroll
      for (int r = 0; r < 16; ++r) { const int t = 32 * tb + crow(r, hi); const int row = rowbase + rstep * t;
          oi[(size_t)row * 512 + h * 128 + 32 * vb + r32] = oo[r]; } }
    __syncthreads();
}
__device__ __forceinline__ void hgrn_scan_phase(const Params& p) {
    const float* __restrict__ U = (const float*)(p.ws + WS_ST); bf16_t* __restrict__ S2 = (bf16_t*)(p.ws + WS_ST2); const float* __restrict__ DEC = (const float*)(p.ws + WS_DEC);
    const int nthr = gridDim.x * 512;
    for (int e = blockIdx.x * 512 + otid(); e < NCHAIN * 4096; e += nthr) {
        const int chain = e >> 12, idx4 = (e & 4095) * 4, k4 = idx4 & 127;
        const float* up = U + (size_t)chain * NCHUNK * 16384 + idx4; bf16_t* sp = S2 + (size_t)chain * NCHUNK * 16384 + idx4; const float* dp = DEC + (size_t)chain * NCHUNK * 128 + k4;
        f32x4 S = {0.f, 0.f, 0.f, 0.f};
#pragma unroll 1
        for (int c0 = 0; c0 < NCHUNK; c0 += 12) {
            f32x4 u[12], d[12];
#pragma unroll
            for (int j = 0; j < 12; ++j) { u[j] = __builtin_nontemporal_load((const f32x4*)(up + (size_t)(c0 + j) * 16384)); d[j] = *(const f32x4*)(dp + (c0 + j) * 128); }
#pragma unroll
            for (int j = 0; j < 12; ++j) { u32x2 w; w.x = cvt_pk_bf16(S[0], S[1]); w.y = cvt_pk_bf16(S[2], S[3]);
                *(u32x2*)(sp + (size_t)(c0 + j) * 16384) = w;
                S = d[j] * S + u[j]; }
        }
    }
}
__device__ __forceinline__ void hgrn_out_job(const Params& p, int l, int job, char* lds) {
    unsigned char* ws = p.ws;
    const int j = job % NCHUNK, h = (job / NCHUNK) & 3, b = job / (NCHUNK * 4);
    const int tid = otid(), lane = tid & 63, wid = tid >> 6, r32 = lane & 31, hi = lane >> 5;
    const int tb = wid >> 2, vb = wid & 3;
    const int row0 = j < 4 ? NLAT + b * CTXL + 64 * j : b * SEQ + 64 * (j - 4);
    const float* oi0 = (const float*)(ws + WS_OI); const float* oi1 = oi0 + (size_t)NTOK * 512;
    const bf16_t* P = (const bf16_t*)(ws + WS_GP);
    const int col = h * 128 + 32 * vb + r32;
    float oiv[16], gv[16];
#pragma unroll
    for (int r = 0; r < 16; ++r) { const int row = row0 + 32 * tb + crow(r, hi);
        oiv[r] = oi0[(size_t)row * 512 + col] + oi1[(size_t)row * 512 + col]; gv[r] = bf2f(P[(size_t)row * INWP + PC_HG + col]); }
    f32x16 acc = {};
#pragma unroll
    for (int dir = 0; dir < 2; ++dir) {
        const int chain = (b * 4 + h) * 2 + dir; const int c = dir == 0 ? j : (j < 4 ? 3 - j : 39 - j);
        const bf16_t* qe = (const bf16_t*)(ws + WS_QE) + ((size_t)(chain * NCHUNK + c)) * 8192;
        const bf16_t* st = (const bf16_t*)(ws + WS_ST2) + ((size_t)(chain * NCHUNK + c)) * 16384;
        const int o = 32 * tb + r32; const int i = dir == 0 ? o : 63 - o;
        bf16x8 a[8], bq[8];
#pragma unroll
        for (int ks = 0; ks < 8; ++ks) { a[ks] = *(const bf16x8*)(qe + i * 128 + 16 * ks + 8 * hi); bq[ks] = *(const bf16x8*)(st + (32 * vb + r32) * 128 + 16 * ks + 8 * hi); }
#pragma unroll
        for (int ks = 0; ks < 8; ++ks) acc = __builtin_amdgcn_mfma_f32_32x32x16_bf16(a[ks], bq[ks], acc, 0, 0, 0);
    }
    float* part = (float*)lds;
    float ov[16];
#pragma unroll
    for (int r = 0; r < 16; ++r) { ov[r] = acc[r] + oiv[r];
        const float ssq = half_sum(ov[r] * ov[r]);
        if (r32 == 0) part[vb * 64 + 32 * tb + crow(r, hi)] = ssq; }
    __syncthreads();
    const float gn = p.in[17][l * 128 + 32 * vb + r32];
    bf16_t* MIX = (bf16_t*)(ws + WS_MIX);
#pragma unroll
    for (int r = 0; r < 16; ++r) { const int tr = 32 * tb + crow(r, hi); const int row = row0 + tr;
        const float tot = part[tr] + part[64 + tr] + part[128 + tr] + part[192 + tr];
        const float g = gv[r];
        const float y = ov[r] * rsqrtf(tot * (1.f / 128) + EPS) * gn * g * __builtin_amdgcn_rcpf(1.f + __builtin_amdgcn_exp2f(-g * LOG2E));
        MIX[(size_t)row * DM + 1024 + col] = f2bf(y); }
    __syncthreads();
}

__device__ __forceinline__ void mixer_queue_phase(const Params& p, int l, char* lds) {
    unsigned char* ws = p.ws;
    unsigned* ctr = (unsigned*)(ws + WS_CTRL) + 16 * (l + 1);
    const bool need_ctx = (l == 0);
    const int nH3 = 16 * NCHUNK, total = 384 + nH3 + (need_ctx ? 48 : 0);
    volatile int* slot = (volatile int*)(lds + LDS_ITEM_OFF);
    bf16_t* MIX = (bf16_t*)(ws + WS_MIX);
    const bf16_t* QA = (const bf16_t*)(ws + WS_QA); const bf16_t* KA = (const bf16_t*)(ws + WS_KA); const bf16_t* VA = (const bf16_t*)(ws + WS_VA);
    const bf16_t* UQ = (const bf16_t*)(ws + WS_UQ); const bf16_t* UKV = (const bf16_t*)(ws + WS_UKV); const bf16_t* KR = (const bf16_t*)(ws + WS_KR);
    const float C_A = 0.08838834764831845f * LOG2E, THR_A = 8.f / 0.08838834764831845f;
    const float C_M = 0.07216878364870323f * LOG2E, THR_M = 8.f / 0.07216878364870323f;
    for (;;) {
        if (threadIdx.x == 0) *slot = (int)atomicAdd(ctr, 1u);
        __syncthreads();
        const int item = *slot;
        __syncthreads();
        if (item >= total) break;
        const int nb = 384 + nH3;
        if (item < 128 || item >= nb + 32) {
            const bool isl = item < 128; const int q = isl ? item : item - nb - 32;
            const int b = isl ? q >> 5 : q >> 2, h = isl ? (q >> 3) & 3 : q & 3, qb = isl ? q & 7 : 0;
            const int qrow0 = isl ? b * SEQ + qb * 256 : NLAT + b * CTXL;
            attn_pipe<192, 768, 1024, 1024>(UQ + (size_t)qrow0 * 768 + h * 128, 512 + h * 64 - h * 128, UKV + h * 256, KR, UKV + h * 256 + 128,
                                              isl ? SEQ : 0, b * SEQ, NLAT + b * CTXL, MIX + (size_t)qrow0 * DM + 1536 + h * 128, isl ? SKV : CTXL, C_M, THR_M, lds);
        } else if (item < 384 || item >= nb) {
            const bool isl = item < 384; const int q = isl ? item - 128 : item - nb;
            const int b = isl ? q >> 6 : q >> 3, h = isl ? (q >> 3) & 7 : q & 7, qb = isl ? q & 7 : 0, kvh = h >> 2;
            const bf16_t* Qp = isl ? QA + ((size_t)(b * 8 + h) * SEQ + qb * 256) * 128 : QA + (size_t)NLAT * 1024 + (size_t)(b * 8 + h) * CTXL * 128;
            const int kr0 = (b * 2 + kvh) * SKV;
            bf16_t* Op = MIX + (size_t)(isl ? b * SEQ + qb * 256 : NLAT + b * CTXL) * DM + h * 128;
            attn_pipe<128, 128, 128, 128>(Qp, 0, KA, KA, VA, isl ? SEQ : 0, kr0, kr0 + SEQ, Op, isl ? SKV : CTXL, C_A, THR_A, lds);
        } else {
            const int q = item - 384, bh = q / NCHUNK, jj = q % NCHUNK;
            if (need_ctx || jj >= 4) hgrn_out_job(p, l, bh * NCHUNK + jj, lds);
        }
        __syncthreads();
    }
}

#define XB_TMO      128
#define XB_XCNT(j)  (256  + 64 * (j))
#define XB_XSUB(j)  (1280 + 64 * (j))
#define XB_XGEN(j)  (2304 + 64 * (j))
#define XB_TOP      3328
#define XB_TOPGEN   3392
#define XCD_BAR_WORDS 3456
#define XB_SPIN_CAP (1u << 18)

__device__ __forceinline__ unsigned xb_ld(unsigned* p)              { return __hip_atomic_load(p, __ATOMIC_RELAXED, __HIP_MEMORY_SCOPE_AGENT); }
__device__ __forceinline__ unsigned xb_add(unsigned* p, unsigned v) { return __hip_atomic_fetch_add(p, v, __ATOMIC_RELAXED, __HIP_MEMORY_SCOPE_AGENT); }
__device__ __forceinline__ unsigned xb_xcc_id() { return (unsigned)__builtin_amdgcn_s_getreg((3 << 11) | 20) & 0xFu; }
#define XB_SPIN(cond, bar) do { unsigned _sp = 0; while (cond) { __builtin_amdgcn_s_sleep(1); \
    if ((++_sp & 255u) == 0u) { if (xb_ld(&(bar)[XB_TMO])) break; if (_sp > XB_SPIN_CAP) { atomicAdd(&(bar)[XB_TMO], 1u); break; } } } } while (0)

struct XcdBarrier {
    unsigned* bar; unsigned x;
    volatile LAS unsigned* st;
};

__device__ __forceinline__ XcdBarrier xcd_barrier_post(unsigned* bar, volatile LAS unsigned* st) {
    XcdBarrier b; b.bar = bar; b.x = xb_xcc_id(); b.st = st;
    if (threadIdx.x == 0) (void)xb_add(&bar[XB_XCNT(b.x)], 1u);
    return b;
}
__device__ __forceinline__ void xcd_barrier_complete(unsigned* bar, unsigned x, unsigned& nloc, unsigned& nx) {
    const unsigned G = gridDim.x * gridDim.y * gridDim.z;
    unsigned sum, cnt, mine, sp = 0u;
    for (;;) {
        sum = 0u; cnt = 0u; mine = 0u;
#pragma unroll
        for (unsigned j = 0; j < 16; ++j) { const unsigned c = xb_ld(&bar[XB_XCNT(j)]); sum += c; cnt += (c > 0u) ? 1u : 0u; mine = (j == x) ? c : mine; }
        if (sum == G) break;
        __builtin_amdgcn_s_sleep(1);
        if ((++sp & 255u) == 0u) { if (xb_ld(&bar[XB_TMO])) break; if (sp > XB_SPIN_CAP) { atomicAdd(&bar[XB_TMO], 1u); break; } }
    }
    nloc = mine > 0u ? mine : 1u; nx = cnt > 0u ? cnt : 1u;
}

__device__ __forceinline__ void xcd_barrier(const XcdBarrier& b) {
    asm volatile("s_waitcnt vmcnt(0)" ::: "memory");
    __syncthreads();
    if (threadIdx.x == 0) {
        unsigned* bar = b.bar;
        __builtin_amdgcn_s_waitcnt(0);
        unsigned nloc = b.st[0], nx = b.st[1];
        if (nloc == 0u) { xcd_barrier_complete(bar, b.x, nloc, nx); b.st[0] = nloc; b.st[1] = nx; }
        const unsigned old = xb_add(&bar[XB_XSUB(b.x)], 1u);
        const unsigned gen = old / nloc;
        if (old + 1u == (gen + 1u) * nloc) {
            __builtin_amdgcn_fence(__ATOMIC_RELEASE, "agent");
            asm volatile("s_waitcnt vmcnt(0)" ::: "memory");
            const unsigned og = xb_add(&bar[XB_TOP], 1u);
            const unsigned tg = og / nx;
            if (og + 1u == (tg + 1u) * nx) xb_add(&bar[XB_TOPGEN], 1u);
            else XB_SPIN(xb_ld(&bar[XB_TOPGEN]) == tg, bar);
            __builtin_amdgcn_fence(__ATOMIC_ACQUIRE, "agent");
            xb_add(&bar[XB_XGEN(b.x)], 1u);
            asm volatile("s_waitcnt vmcnt(0)" ::: "memory");
        } else {
            XB_SPIN(xb_ld(&bar[XB_XGEN(b.x)]) == gen, bar);
            __builtin_amdgcn_fence(__ATOMIC_ACQUIRE, "agent");
            asm volatile("s_waitcnt vmcnt(0)" ::: "memory");
        }
    }
    __syncthreads();
}

__device__ __forceinline__ void grid_barrier(unsigned* ctr, unsigned& epoch, const unsigned G) {
    asm volatile("s_waitcnt vmcnt(0) lgkmcnt(0)" ::: "memory");
    __syncthreads();
    epoch += G;
    if (threadIdx.x == 0) {
        __builtin_amdgcn_fence(__ATOMIC_RELEASE, "agent");
        asm volatile("s_waitcnt vmcnt(0)" ::: "memory");
        __hip_atomic_fetch_add(ctr, 1u, __ATOMIC_RELAXED, __HIP_MEMORY_SCOPE_AGENT);
        while (__hip_atomic_load(ctr, __ATOMIC_RELAXED, __HIP_MEMORY_SCOPE_AGENT) < epoch) __builtin_amdgcn_s_sleep(1);
        __builtin_amdgcn_fence(__ATOMIC_ACQUIRE, "agent");
        asm volatile("s_waitcnt vmcnt(0)" ::: "memory");
    }
    __syncthreads();
}

constexpr int NPH = 27;
__global__ void __launch_bounds__(512) fwd_megakernel(Params p) {
    extern __shared__ __attribute__((aligned(16))) unsigned char smem[];
    char* lds = (char*)smem;
    LAS unsigned char* ldsl = (LAS unsigned char*)smem;
    cg::grid_group grid = cg::this_grid();
    unsigned char* ws = p.ws;
    const int tid = threadIdx.x, G = gridDim.x, bid = blockIdx.x;
#define PHASE(n) if (p.ph_lo <= (n) && (n) < p.ph_hi)
#define SYNC(n) do { if (p.ph_lo <= (n) && (n) + 1 < p.ph_hi) { xcd_barrier(xbar); } } while (0)
    volatile LAS unsigned* xst = (volatile LAS unsigned*)(ldsl + LDS_ITEM_OFF + 16);
    if (tid == 0) { xst[0] = 0u; xst[1] = 0u; }
    __syncthreads();
    XcdBarrier xbar = xcd_barrier_post((unsigned*)(ws + WS_BAR), xst);
    if (p.ph_lo < 0) grid.sync();
    float* X = (float*)(ws + WS_X); bf16_t* H = (bf16_t*)(ws + WS_H); bf16_t* Gb = (bf16_t*)(ws + WS_GP); float* Pb = (float*)(ws + WS_GP);
    bf16_t* MIX = (bf16_t*)(ws + WS_MIX);
    const float* MOD = (const float*)(ws + WS_MOD);
    float* PART = (float*)(ws + WS_PART); const bool split_ok = (G == 256);

    PHASE(0) {
        if (bid == 0 && tid < 64) ((unsigned*)(ws + WS_CTRL))[tid] = 0u;
        if (bid == G - 1) rope_tables(p);
        { const size_t nc4 = (size_t)NCTX * DM / 4;
          for (size_t i = (size_t)bid * 512 + tid; i < nc4; i += (size_t)G * 512) ((f32x4*)(X + (size_t)NLAT * DM))[i] = ((const f32x4*)p.in[2])[i]; }
        { bool first = true; for (int it = bid; it < N_GEMV; it += G) { gemv_item(p, it, lds, first); first = false; } }
        if (G == 256) {
            const int nvw = 32 + 224 * 3, w0 = bid < 32 ? bid : 32 + (bid - 32) * 3, nw = bid < 32 ? 1 : 3;
#pragma unroll 1
            for (int w = w0; w < w0 + nw; ++w) { transpose_set(p, 0, 1, w, nvw, lds); transpose_set(p, 0, 0, w, nvw, lds); transpose_set(p, 1, 0, w, nvw, lds); }
        } else { transpose_set(p, 0, 1, bid, G, lds); transpose_set(p, 0, 0, bid, G, lds); transpose_set(p, 1, 0, bid, G, lds); }
        if (G <= 12) { transpose_set(p, 0, 2, bid, G, lds); transpose_set(p, 1, 1, bid, G, lds); transpose_set(p, 1, 2, bid, G, lds); }
    }
    SYNC(0);
#pragma unroll 1
    for (int l = 0; l < 2; ++l) {
        const int pb = 2 + 12 * l;
        const float* modl = MOD + (size_t)l * 5 * MODW;
        const bool last = (l == 1);
        PHASE(pb + 0) norm_phase(X, H, modl, 0, 1, NTOK, (l > 0 && split_ok) ? PART : nullptr, l == 0 ? p.in[0] : nullptr);
        SYNC(pb + 0);
        PHASE(pb + 1) { pg8::Gemm g{H, (const bf16_t*)(ws + WS_W1IN + l * SZ_WFIN), NTOK, 2 * FH, DM}; pg8::StaticOrder S; S.init(g.M, g.N, g.K, G, bid, 0); EpiSwiglu E{Gb}; pg8::gemm_phase(ldsl, g, S, E);
            if (G > 12 && bid >= 12) transpose_set(p, l, 2, bid - 12, G - 12, lds, 0, G == 256 ? 3 : 4); }
        SYNC(pb + 1);
        PHASE(pb + 2) { pg8::Gemm g{Gb, (const bf16_t*)(ws + WS_W1OUT + l * SZ_WFOUT), NTOK, DM, FH}; pg8::StaticOrder S; S.init(g.M, g.N, g.K, G, bid, 1); EpiResid E{X, PART, l == 0 ? p.in[0] : X, modl + 2 * DM, 0.5f}; pg8::gemm_phase(ldsl, g, S, E); }
        SYNC(pb + 2);
        PHASE(pb + 3) norm_phase(X, H, modl, 3, 4, NTOK, split_ok ? PART : nullptr, nullptr);
        SYNC(pb + 3);
        PHASE(pb + 4) { pg8::Gemm g{H, (const bf16_t*)(ws + WS_WIN + l * SZ_WIN), NTOK, INWP, DM}; pg8::StaticOrder S; S.init(g.M, g.N, g.K, G, bid, 0); EpiBf16 E{(bf16_t*)Pb, INWP, -1, nullptr, nullptr}; pg8::gemm_phase(ldsl, g, S, E);
            if (G == 256 && bid >= 208) transpose_set(p, l, 2, bid - 208, 48, lds, 3, 4); }
        SYNC(pb + 4);
        PHASE(pb + 5) {
            prep_phase(p, l);
            for (int job = bid; job < NCHAIN * NCHUNK; job += G) hgrn_chunk_job(p, l, job, lds);
        }
        SYNC(pb + 5);
        PHASE(pb + 6) {
            const float* tab = (const float*)(ws + WS_ROPE);
            { pg8::Gemm g{(const bf16_t*)(ws + WS_CQN), (const bf16_t*)(ws + WS_WUQ + l * SZ_WUQ), NTOK, 768, 512}; pg8::StaticOrder S; S.init(g.M, g.N, g.K, G, bid, 0);
              EpiBf16 E{(bf16_t*)(ws + WS_UQ), 768, 2, tab + 4096, tab + 5120}; pg8::gemm_phase(ldsl, g, S, E); }
            { pg8::Gemm g{(const bf16_t*)(ws + WS_CKVN), (const bf16_t*)(ws + WS_WUKV + l * SZ_WUKV), NTOK, 1024, 256}; pg8::StaticOrder S; S.init(g.M, g.N, g.K, G, (bid + G - 108) % G, 0);
              EpiBf16 E{(bf16_t*)(ws + WS_UKV), 1024, -1, tab + 4096, tab + 5120}; pg8::gemm_phase(ldsl, g, S, E); }
            hgrn_scan_phase(p);
        }
        SYNC(pb + 6);
        PHASE(pb + 7) mixer_queue_phase(p, l, lds);
        SYNC(pb + 7);
        const int Mrows = last ? NLAT : NTOK;
        PHASE(pb + 8) { pg8::Gemm g{MIX, (const bf16_t*)(ws + WS_WOUT + l * SZ_WOUT), Mrows, DM, DM}; pg8::StaticOrder S; S.init(g.M, g.N, g.K, G, bid, 1); EpiResid E{X, PART, X, modl + 5 * DM, 1.0f}; pg8::gemm_phase(ldsl, g, S, E); }
        SYNC(pb + 8);
        PHASE(pb + 9) norm_phase(X, H, modl, 6, 7, Mrows, (!last && split_ok) ? PART : nullptr, nullptr);
        SYNC(pb + 9);
        PHASE(pb + 10) { pg8::Gemm g{H, (const bf16_t*)(ws + WS_W2IN + l * SZ_WFIN), Mrows, 2 * FH, DM}; pg8::StaticOrder S; S.init(g.M, g.N, g.K, G, bid, 0); EpiSwiglu E{Gb}; pg8::gemm_phase(ldsl, g, S, E);
            if (!last && G > 12 && bid >= 12) transpose_set(p, 1, 1, bid - 12, G - 12, lds); }
        SYNC(pb + 10);
        PHASE(pb + 11) { pg8::Gemm g{Gb, (const bf16_t*)(ws + WS_W2OUT + l * SZ_WFOUT), Mrows, DM, FH}; pg8::StaticOrder S; S.init(g.M, g.N, g.K, G, bid, 1); EpiResid E{X, PART, X, modl + 8 * DM, 0.5f}; pg8::gemm_phase(ldsl, g, S, E); }
        SYNC(pb + 11);
    }
    PHASE(26) final_phase(X, p.out, p.in[20]);
#undef PHASE
#undef SYNC
}

extern "C" void kernel_launch(void* const* d_in, const int* in_sizes, int n_in, void* d_out, int out_size, void* d_ws, size_t ws_size, hipStream_t stream) {
    static int grid_blocks = 0;
    if (grid_blocks == 0) {
        if (n_in != 21 || ws_size < WS_END) { fprintf(stderr, "kernel_launch: n_in %d ws %zu (need %zu)\n", n_in, ws_size, (size_t)WS_END); grid_blocks = -1; return; }
        int dev = 0, cus = 0, per_cu = 0;
        (void)hipGetDevice(&dev);
        (void)hipDeviceGetAttribute(&cus, hipDeviceAttributeMultiprocessorCount, dev);
        if (hipFuncSetAttribute((const void*)fwd_megakernel, hipFuncAttributeMaxDynamicSharedMemorySize, LDS_BYTES) != hipSuccess) { fprintf(stderr, "kernel_launch: hipFuncSetAttribute failed\n"); grid_blocks = -1; return; }
        (void)hipOccupancyMaxActiveBlocksPerMultiprocessor(&per_cu, (const void*)fwd_megakernel, 512, LDS_BYTES);
        if (per_cu < 1) { fprintf(stderr, "kernel_launch: occupancy query says %d\n", per_cu); per_cu = 1; }
        grid_blocks = cus * 1;
        (void)hipGetLastError();
    }
    if (grid_blocks < 0) return;
    (void)hipMemsetAsync((char*)d_ws + WS_BAR, 0, 16384, stream);
    Params p{};
    for (int i = 0; i < 21; ++i) p.in[i] = (const float*)d_in[i];
    p.out = (float*)d_out; p.ws = (unsigned char*)d_ws;
#if ONE_LAUNCH
    p.ph_lo = 0; p.ph_hi = NPH;
    void* args[] = {&p};
    hipError_t e = hipLaunchCooperativeKernel((const void*)fwd_megakernel, dim3(grid_blocks), dim3(512), args, LDS_BYTES, stream);
    if (e != hipSuccess) fprintf(stderr, "cooperative launch failed: %s (grid %d)\n", hipGetErrorString(e), grid_blocks);
#else
    for (int ph = 0; ph < NPH; ++ph) { p.ph_lo = ph; p.ph_hi = ph + 1; hipLaunchKernelGGL(fwd_megakernel, dim3(grid_blocks), dim3(512), LDS_BYTES, stream, p); }
#endif
}
```
